# Optimizing an MI355X kernel written in HIP

```python
import jax, jax.numpy as jnp
from jax import lax
import numpy as np

D_MODEL = 2048
BATCH = 4
SEQ = 4096
DEPTH = 4

HEAD_DIM = 128
FOX_HEADS = D_MODEL // (2 * HEAD_DIM)
SWA_Q_HEADS = D_MODEL // (2 * HEAD_DIM)
SWA_KV_HEADS = 2
SWA_GROUP = SWA_Q_HEADS // SWA_KV_HEADS
SWA_WINDOW = 128
Q_BLOCK = 128
ROPE_THETA = 10000.0
MLSTM_HEADS = 8
MLSTM_QK_DIM = D_MODEL // (2 * MLSTM_HEADS)
MLSTM_V_DIM = D_MODEL // MLSTM_HEADS
MLSTM_CHUNK = 64
D_FF = 5632
CONV_WIDTH = 3
LN_EPS = 1e-5
DEEPNORM_ALPHA = (2 * DEPTH) ** 0.25
DEEPNORM_BETA = (8 * DEPTH) ** -0.25
FORGET_BIAS_INIT = 3.0
N_EVEN = (DEPTH + 1) // 2
N_ODD = DEPTH // 2

FOX_DIM = FOX_HEADS * HEAD_DIM
SWA_Q_DIM = SWA_Q_HEADS * HEAD_DIM
SWA_KV_DIM = SWA_KV_HEADS * HEAD_DIM
ATTN_SPLIT_SIZES = (FOX_DIM, FOX_DIM, FOX_DIM, FOX_HEADS, SWA_Q_DIM, SWA_KV_DIM, SWA_KV_DIM)
ATTN_IN_DIM = 3 * FOX_DIM + FOX_HEADS + SWA_Q_DIM + 2 * SWA_KV_DIM
FOX_F_OFF = 3 * FOX_DIM
ATTN_OUT_DIM = FOX_DIM + SWA_Q_DIM

MLSTM_QK_TOT = MLSTM_HEADS * MLSTM_QK_DIM
MLSTM_V_TOT = MLSTM_HEADS * MLSTM_V_DIM
MLSTM_SPLIT_SIZES = (MLSTM_QK_TOT, MLSTM_QK_TOT, MLSTM_V_TOT, MLSTM_V_TOT, MLSTM_HEADS, MLSTM_HEADS)
MLSTM_IN_DIM = 2 * MLSTM_QK_TOT + 2 * MLSTM_V_TOT + 2 * MLSTM_HEADS
MLSTM_F_OFF = 2 * MLSTM_QK_TOT + 2 * MLSTM_V_TOT + MLSTM_HEADS

kernel_name = "fox_swa_sink_mlstm_convffn_deepnorm_hybrid"


def split_columns(a, sizes):
    out, off = [], 0
    for s in sizes:
        out.append(a[..., off:off + s])
        off += s
    return out


def layer_norm(x, g, b):
    xf = x.astype(jnp.float32)
    mu = jnp.mean(xf, axis=-1, keepdims=True)
    var = jnp.mean(jnp.square(xf - mu), axis=-1, keepdims=True)
    y = (xf - mu) * lax.rsqrt(var + LN_EPS)
    return (y * g.astype(jnp.float32) + b.astype(jnp.float32)).astype(x.dtype)


def apply_rope(x):
    S = x.shape[1]
    half = HEAD_DIM // 2
    inv_freq = jnp.power(ROPE_THETA, -jnp.arange(half, dtype=jnp.float32) * (2.0 / HEAD_DIM))
    ang = jnp.arange(S, dtype=jnp.float32)[:, None] * inv_freq[None, :]
    cos = jnp.cos(ang)[None, :, None, :]
    sin = jnp.sin(ang)[None, :, None, :]
    xf = x.astype(jnp.float32)
    x1, x2 = xf[..., :half], xf[..., half:]
    return jnp.concatenate([x1 * cos - x2 * sin, x2 * cos + x1 * sin], axis=-1).astype(x.dtype)


def fox_attention(q, k, v, log_f):
    B, S, H, d = q.shape
    nb = S // Q_BLOCK
    scale = d ** -0.5
    c = jnp.cumsum(log_f, axis=1)
    c_k = jnp.transpose(c, (0, 2, 1))
    q_blocks = jnp.transpose(q.reshape(B, nb, Q_BLOCK, H, d), (1, 0, 2, 3, 4))
    c_blocks = jnp.transpose(c.reshape(B, nb, Q_BLOCK, H), (1, 0, 3, 2))
    k_pos = jnp.arange(S)

    def one_block(args):
        qi, cqi, i = args
        s = jnp.einsum('bqhd,bkhd->bhqk', qi, k, preferred_element_type=jnp.float32) * scale
        s = s + (cqi[..., :, None] - c_k[:, :, None, :])
        q_pos = i * Q_BLOCK + jnp.arange(Q_BLOCK)
        causal = k_pos[None, :] <= q_pos[:, None]
        s = jnp.where(causal[None, None], s, -jnp.inf)
        p = jax.nn.softmax(s, axis=-1)
        o = jnp.einsum('bhqk,bkhd->bqhd', p.astype(v.dtype), v, preferred_element_type=jnp.float32)
        return o.astype(q.dtype)

    out = lax.map(one_block, (q_blocks, c_blocks, jnp.arange(nb)))
    return jnp.transpose(out, (1, 0, 2, 3, 4)).reshape(B, S, H * d)


def swa_sink_attention(q, k, v, sinks):
    B, S, Hq, d = q.shape
    W = SWA_WINDOW
    nb = S // W
    scale = d ** -0.5
    qb = q.reshape(B, nb, W, SWA_KV_HEADS, SWA_GROUP, d)
    kb = k.reshape(B, nb, W, SWA_KV_HEADS, d)
    vb = v.reshape(B, nb, W, SWA_KV_HEADS, d)
    k_prev = jnp.concatenate([jnp.zeros_like(kb[:, :1]), kb[:, :-1]], axis=1)
    v_prev = jnp.concatenate([jnp.zeros_like(vb[:, :1]), vb[:, :-1]], axis=1)
    k_win = jnp.concatenate([k_prev, kb], axis=2)
    v_win = jnp.concatenate([v_prev, vb], axis=2)
    s = jnp.einsum('bnqkgd,bnskd->bnkgqs', qb, k_win, preferred_element_type=jnp.float32) * scale
    blk = jnp.arange(nb)[:, None, None]
    q_pos = blk * W + jnp.arange(W)[None, :, None]
    k_pos = (blk - 1) * W + jnp.arange(2 * W)[None, None, :]
    valid = (k_pos <= q_pos) & (k_pos > q_pos - W) & (k_pos >= 0)
    s = jnp.where(valid[None, :, None, None], s, -jnp.inf)
    sink = sinks.astype(jnp.float32).reshape(SWA_KV_HEADS, SWA_GROUP)[None, None, :, :, None, None]
    m = jnp.maximum(jnp.max(s, axis=-1, keepdims=True), sink)
    p = jnp.exp(s - m)
    denom = jnp.sum(p, axis=-1, keepdims=True) + jnp.exp(sink - m)
    o = jnp.einsum('bnkgqs,bnskd->bnqkgd', (p / denom).astype(v.dtype), v_win,
                   preferred_element_type=jnp.float32)
    return o.astype(q.dtype).reshape(B, S, Hq * d)


def mlstm_chunkwise(q, k, v, i_pre, f_pre):
    B, S, H, dk = q.shape
    dv = v.shape[-1]
    L = MLSTM_CHUNK
    nc = S // L
    qf = q.astype(jnp.float32)
    kf = k.astype(jnp.float32) * (dk ** -0.5)
    vf = v.astype(jnp.float32)
    log_f = jax.nn.log_sigmoid(f_pre)

    def to_chunks(a):
        return jnp.transpose(a.reshape(B, nc, L, H, a.shape[-1]), (1, 0, 3, 2, 4))

    def gate_chunks(a):
        return jnp.transpose(a.reshape(B, nc, L, H), (1, 0, 3, 2))

    qc, kc, vc = to_chunks(qf), to_chunks(kf), to_chunks(vf)
    ic = gate_chunks(i_pre)
    b = jnp.cumsum(gate_chunks(log_f), axis=-1)
    b_last = b[..., -1]
    tri = jnp.arange(L)[:, None] >= jnp.arange(L)[None, :]
    d_log = jnp.where(tri, b[..., :, None] - b[..., None, :] + ic[..., None, :], -jnp.inf)
    m_intra = jnp.max(d_log, axis=-1)
    g = b_last[..., None] - b + ic

    def step(carry, inp):
        Cs, ns, m = carry
        qx, kx, vx, bx, dx, mi, gx, bl = inp
        m_inter = bx + m[..., None]
        m_t = jnp.maximum(m_inter, mi)
        inter = jnp.exp(m_inter - m_t)
        w = jnp.exp(dx - m_t[..., None])
        sm = w * jnp.einsum('bhtd,bhsd->bhts', qx, kx)
        num = inter[..., None] * jnp.einsum('bhvd,bhtd->bhtv', Cs, qx) + jnp.einsum('bhts,bhsv->bhtv', sm, vx)
        dot = inter * jnp.einsum('bhd,bhtd->bht', ns, qx) + jnp.sum(sm, axis=-1)
        den = jnp.maximum(jnp.abs(dot), jnp.exp(-m_t))
        h = num / den[..., None]
        m_new = jnp.maximum(bl + m, jnp.max(gx, axis=-1))
        decay = jnp.exp(bl + m - m_new)
        wg = jnp.exp(gx - m_new[..., None])
        Cs_new = decay[..., None, None] * Cs + jnp.einsum('bhsv,bhsd->bhvd', vx * wg[..., None], kx)
        ns_new = decay[..., None] * ns + jnp.einsum('bhs,bhsd->bhd', wg, kx)
        return (Cs_new, ns_new, m_new), h

    init = (jnp.zeros((B, H, dv, dk), jnp.float32), jnp.zeros((B, H, dk), jnp.float32),
            jnp.zeros((B, H), jnp.float32))
    _, hs = lax.scan(step, init, (qc, kc, vc, b, d_log, m_intra, g, b_last))
    return jnp.transpose(hs, (1, 0, 3, 2, 4)).reshape(B, S, H * dv)


def attention_mixer(x, w_in, b_in, sinks, w_out):
    B, S, _ = x.shape
    proj = jnp.einsum('bsd,de->bse', x, w_in) + b_in
    fq, fk, fv, ff, sq, sk, sv = split_columns(proj, ATTN_SPLIT_SIZES)
    fox_out = fox_attention(fq.reshape(B, S, FOX_HEADS, HEAD_DIM), fk.reshape(B, S, FOX_HEADS, HEAD_DIM),
                            fv.reshape(B, S, FOX_HEADS, HEAD_DIM),
                            jax.nn.log_sigmoid(ff.astype(jnp.float32)))
    swa_out = swa_sink_attention(apply_rope(sq.reshape(B, S, SWA_Q_HEADS, HEAD_DIM)),
                                 apply_rope(sk.reshape(B, S, SWA_KV_HEADS, HEAD_DIM)),
                                 sv.reshape(B, S, SWA_KV_HEADS, HEAD_DIM), sinks)
    heads = jnp.concatenate([fox_out, swa_out], axis=-1)
    return jnp.einsum('bse,ed->bsd', heads, w_out)


def mlstm_mixer(x, w_in, b_in, w_out):
    B, S, _ = x.shape
    proj = jnp.einsum('bsd,de->bse', x, w_in) + b_in
    q, k, v, o, ig, fg = split_columns(proj, MLSTM_SPLIT_SIZES)
    h = mlstm_chunkwise(q.reshape(B, S, MLSTM_HEADS, MLSTM_QK_DIM), k.reshape(B, S, MLSTM_HEADS, MLSTM_QK_DIM),
                        v.reshape(B, S, MLSTM_HEADS, MLSTM_V_DIM), ig.astype(jnp.float32), fg.astype(jnp.float32))
    h = (jax.nn.sigmoid(o.astype(jnp.float32)) * h).astype(x.dtype)
    return jnp.einsum('bse,ed->bsd', h, w_out)


def conv_ffn(x, w_up, conv_w, conv_b, w_down):
    S = x.shape[1]
    u = jnp.einsum('bsd,df->bsf', x, w_up)
    u_pad = jnp.pad(u, ((0, 0), (CONV_WIDTH - 1, 0), (0, 0)))
    c = conv_b + sum(conv_w[j] * u_pad[:, j:j + S] for j in range(CONV_WIDTH))
    gate, val = c[..., :D_FF], c[..., D_FF:]
    return jnp.einsum('bsf,fd->bsd', jax.nn.silu(gate) * val, w_down)


def setup_inputs(seed: int = 0) -> dict:
    key = jax.random.key(seed)
    ks = jax.random.split(key, 20)
    f32 = jnp.float32

    def nrm(k, shape, scale):
        return jax.random.normal(k, shape, f32) * scale

    x = nrm(ks[0], (BATCH, SEQ, D_MODEL), 1.0)
    attn_w_in = nrm(ks[1], (N_EVEN, D_MODEL, ATTN_IN_DIM), D_MODEL ** -0.5)
    attn_b_in = nrm(ks[2], (N_EVEN, ATTN_IN_DIM), 0.02).at[:, FOX_F_OFF:FOX_F_OFF + FOX_HEADS].add(FORGET_BIAS_INIT)
    attn_sinks = nrm(ks[3], (N_EVEN, SWA_Q_HEADS), 0.5)
    attn_w_out = nrm(ks[4], (N_EVEN, ATTN_OUT_DIM, D_MODEL), ATTN_OUT_DIM ** -0.5 * DEEPNORM_BETA)
    mlstm_w_in = nrm(ks[5], (N_ODD, D_MODEL, MLSTM_IN_DIM), D_MODEL ** -0.5)
    mlstm_b_in = nrm(ks[6], (N_ODD, MLSTM_IN_DIM), 0.02).at[:, MLSTM_F_OFF:MLSTM_F_OFF + MLSTM_HEADS].add(FORGET_BIAS_INIT)
    mlstm_w_out = nrm(ks[7], (N_ODD, MLSTM_V_TOT, D_MODEL), MLSTM_V_TOT ** -0.5 * DEEPNORM_BETA)
    ffn_w_up = nrm(ks[8], (DEPTH, D_MODEL, 2 * D_FF), D_MODEL ** -0.5)
    ffn_conv_w = nrm(ks[9], (DEPTH, CONV_WIDTH, 2 * D_FF), CONV_WIDTH ** -0.5)
    ffn_conv_b = nrm(ks[10], (DEPTH, 2 * D_FF), 0.02)
    ffn_w_down = nrm(ks[11], (DEPTH, D_FF, D_MODEL), D_FF ** -0.5 * DEEPNORM_BETA)
    ln1_g = 1.0 + nrm(ks[12], (DEPTH, D_MODEL), 0.02)
    ln1_b = nrm(ks[13], (DEPTH, D_MODEL), 0.02)
    ln2_g = 1.0 + nrm(ks[14], (DEPTH, D_MODEL), 0.02)
    ln2_b = nrm(ks[15], (DEPTH, D_MODEL), 0.02)
    return {"x": x, "attn_w_in": attn_w_in, "attn_b_in": attn_b_in, "attn_sinks": attn_sinks,
            "attn_w_out": attn_w_out, "mlstm_w_in": mlstm_w_in, "mlstm_b_in": mlstm_b_in,
            "mlstm_w_out": mlstm_w_out, "ffn_w_up": ffn_w_up, "ffn_conv_w": ffn_conv_w,
            "ffn_conv_b": ffn_conv_b, "ffn_w_down": ffn_w_down, "ln1_g": ln1_g, "ln1_b": ln1_b,
            "ln2_g": ln2_g, "ln2_b": ln2_b}


def reference(x, attn_w_in, attn_b_in, attn_sinks, attn_w_out, mlstm_w_in, mlstm_b_in, mlstm_w_out,
              ffn_w_up, ffn_conv_w, ffn_conv_b, ffn_w_down, ln1_g, ln1_b, ln2_g, ln2_b):
    for layer in range(DEPTH):
        j = layer // 2
        if layer % 2 == 0:
            y = attention_mixer(x, attn_w_in[j], attn_b_in[j], attn_sinks[j], attn_w_out[j])
        else:
            y = mlstm_mixer(x, mlstm_w_in[j], mlstm_b_in[j], mlstm_w_out[j])
        x = layer_norm(DEEPNORM_ALPHA * x + y, ln1_g[layer], ln1_b[layer])
        y = conv_ffn(x, ffn_w_up[layer], ffn_conv_w[layer], ffn_conv_b[layer], ffn_w_down[layer])
        x = layer_norm(DEEPNORM_ALPHA * x + y, ln2_g[layer], ln2_b[layer])
    return x
```

```cpp
#include <hip/hip_runtime.h>
#include <cstdio>
#include <cstdint>

constexpr int DM = 2048, NBATCH = 4, SEQ = 4096, MTOK = NBATCH * SEQ, DEPTH = 4;
constexpr int HD = 128, FOXH = 8, SWAQ = 8, SWAKV = 2, SWAW = 128;
constexpr int ATT_IN = 4616, ATT_N = 4608;
constexpr int ML_IN = 6160, ML_N = 6144;
constexpr int MLH = 8, MLDK = 128, MLDV = 256, MLCH = 64;
constexpr int DFF = 5632, UPN = 2 * DFF;
constexpr float LN_EPS = 1e-5f;
constexpr float DN_ALPHA = 1.6817928305074290f;
constexpr int A_FQ = 0, A_FK = 1024, A_FV = 2048, A_SQ = 3072, A_SK = 4096, A_SV = 4352;
constexpr int L_Q = 0, L_K = 1024, L_V = 2048, L_O = 4096;

#define USE_NAIVE 1
#ifndef USE_NAIVE
#define USE_NAIVE 0
#endif
namespace pg8 {
#define PG8_LAS __attribute__((address_space(3)))
typedef unsigned short bf16_t;
typedef short bf16x8 __attribute__((ext_vector_type(8)));
typedef float f32x4 __attribute__((ext_vector_type(4)));
typedef unsigned u32x4 __attribute__((ext_vector_type(4)));
constexpr int BM = 256, BK = 64, HALF = 128, HTB = HALF * BK * 2  , STAGE_BYTES = 8 * HTB, NXCD = 8, WGM = 8;

__host__ __device__ __forceinline__ int lds_byte(int r, int c) { const int st = (r >> 4) * 2 + (c >> 5), rr = r & 15, cc = c & 31, ob = rr * 64 + cc * 2; return st * 1024 + (ob ^ (((ob >> 9) & 1) << 5)); }
__host__ __device__ __forceinline__ void stage_rc(int b, int& R, int& C) { const int st = b / 1024, sb = b % 1024, swz = sb ^ (((sb >> 9) & 1) << 5); R = (st >> 1) * 16 + swz / 64; C = (st & 1) * 32 + (swz % 64) / 2; }
__host__ __device__ __forceinline__ int perm32(int rho) { const int n = rho >> 4, i = rho & 15; return 8 * (i >> 2) + 4 * n + (i & 3); }

struct Unit { int pm, pn; };
struct Gemm { const bf16_t* A; const bf16_t* Bt; int M, N, K; };

struct StaticOrder {
    int nM, nN, nwg, G, c;
    __host__ __device__ void init(int M, int N, int G_, int c_) { nM = M / BM; nN = N / BM; nwg = nM * nN; G = G_; c = c_; }
    __host__ __device__ bool next(int i, Unit& u) const {
        const long L = (long)i * G + c; if (L >= nwg) return false;
        int wgid = (int)L; { const int q = nwg / NXCD, r = nwg % NXCD, xcd = wgid % NXCD, off = wgid / NXCD; wgid = (xcd < r ? xcd * (q + 1) : r * (q + 1) + (xcd - r) * q) + off; }
        const int nig = WGM * nN, gid = wgid / nig, fm = gid * WGM, gsz = (nM - fm) < WGM ? (nM - fm) : WGM;
        u.pm = fm + ((wgid % nig) % gsz); u.pn = (wgid % nig) / gsz; return true;
    }
    __device__ __forceinline__ void a_ready(const Unit&) const {}
    __device__ __forceinline__ void done(const Unit&) const {}
};
__device__ __forceinline__ unsigned cvt_pk_bf16(float lo, float hi) { unsigned r; asm volatile("v_cvt_pk_bf16_f32 %0, %1, %2" : "=v"(r) : "v"(lo), "v"(hi)); return r; }
typedef float f32x2 __attribute__((ext_vector_type(2)));
typedef unsigned u32x2 __attribute__((ext_vector_type(2)));
struct EpiStoreBf16 {
    static constexpr bool PERM = true, AFTER_DRAIN = false;
    bf16_t* O; int ldc;
    __device__ __forceinline__ void operator()(const f32x4 (&acc)[2][2][4][2], const Unit& u, int wr, int wc, int fr, int fq) const {
        const int row0 = u.pm * BM + wr * 64 + fr, col0 = u.pn * BM + wc * 32 + 8 * fq;
#pragma unroll
        for (int ai = 0; ai < 2; ++ai)
#pragma unroll
            for (int m = 0; m < 4; ++m) { bf16_t* rowp = O + (size_t)(row0 + ai * HALF + m * 16) * ldc + col0;
#pragma unroll
                for (int bj = 0; bj < 2; ++bj) { const f32x4 v0 = acc[ai][bj][m][0], v1 = acc[ai][bj][m][1];
                    u32x4 w; w.x = cvt_pk_bf16(v0[0], v0[1]); w.y = cvt_pk_bf16(v0[2], v0[3]); w.z = cvt_pk_bf16(v1[0], v1[1]); w.w = cvt_pk_bf16(v1[2], v1[3]);
                    *(u32x4*)(rowp + bj * HALF) = w; } }
    }
};
struct EpiProj {
    static constexpr bool PERM = true, AFTER_DRAIN = false;
    bf16_t* O; int ldc; const float* bias; int rope_lo, rope_hi; const float* rope;
    __device__ __forceinline__ void operator()(const f32x4 (&acc)[2][2][4][2], const Unit& u, int wr, int wc, int fr, int fq) const {
        const int row0 = u.pm * BM + wr * 64 + fr, col0 = u.pn * BM + wc * 32 + 8 * fq;
        const bool rp = (u.pn >= rope_lo) && (u.pn < rope_hi);
        f32x4 bv[2][2];
#pragma unroll
        for (int bj = 0; bj < 2; ++bj)
#pragma unroll
            for (int n = 0; n < 2; ++n) bv[bj][n] = *(const f32x4*)(bias + col0 + bj * HALF + 4 * n);
        const int f0 = wc * 16 + 4 * fq;
#pragma unroll
        for (int ai = 0; ai < 2; ++ai)
#pragma unroll
            for (int m = 0; m < 4; ++m) { const int row = row0 + ai * HALF + m * 16; bf16_t* rowp = O + (size_t)row * ldc + col0;
                f32x4 cs0 = (f32x4){1.f, 0.f, 1.f, 0.f}, cs1 = cs0;
                if (rp) { const float* rt = rope + ((size_t)(row & (4096 - 1)) * 64 + f0) * 2; cs0 = *(const f32x4*)rt; cs1 = *(const f32x4*)(rt + 4); }
#pragma unroll
                for (int bj = 0; bj < 2; ++bj) { f32x4 v0 = acc[ai][bj][m][0] + bv[bj][0], v1 = acc[ai][bj][m][1] + bv[bj][1];
                    if (rp) { const f32x4 a = v0, b = v1;
                        v0[0] = a[0] * cs0[0] - a[1] * cs0[1]; v0[1] = a[1] * cs0[0] + a[0] * cs0[1];
                        v0[2] = a[2] * cs0[2] - a[3] * cs0[3]; v0[3] = a[3] * cs0[2] + a[2] * cs0[3];
                        v1[0] = b[0] * cs1[0] - b[1] * cs1[1]; v1[1] = b[1] * cs1[0] + b[0] * cs1[1];
                        v1[2] = b[2] * cs1[2] - b[3] * cs1[3]; v1[3] = b[3] * cs1[2] + b[2] * cs1[3]; }
                    u32x4 w; w.x = cvt_pk_bf16(v0[0], v0[1]); w.y = cvt_pk_bf16(v0[2], v0[3]); w.z = cvt_pk_bf16(v1[0], v1[1]); w.w = cvt_pk_bf16(v1[2], v1[3]);
                    *(u32x4*)(rowp + bj * HALF) = w; } }
    }
};
struct EpiResid {
    static constexpr bool PERM = false, AFTER_DRAIN = false;
    float* X; int ldc; float alpha;
    __device__ __forceinline__ void operator()(const f32x4 (&acc)[2][2][4][2], const Unit& u, int wr, int wc, int fr, int fq) const {
        const int row0 = u.pm * BM + wr * 64 + fr, col0 = u.pn * BM + wc * 32 + 4 * fq;
#pragma unroll
        for (int ai = 0; ai < 2; ++ai)
#pragma unroll
            for (int m = 0; m < 4; ++m) { float* rowp = X + (size_t)(row0 + ai * HALF + m * 16) * ldc + col0;
                f32x4 xv[2][2];
#pragma unroll
                for (int bj = 0; bj < 2; ++bj)
#pragma unroll
                    for (int n = 0; n < 2; ++n) xv[bj][n] = *(const f32x4*)(rowp + bj * HALF + n * 16);
#pragma unroll
                for (int bj = 0; bj < 2; ++bj)
#pragma unroll
                    for (int n = 0; n < 2; ++n) *(f32x4*)(rowp + bj * HALF + n * 16) = xv[bj][n] * alpha + acc[ai][bj][m][n];
                asm volatile("" ::: "memory"); }
    }
};

template <class Epi, class Sched, bool ALIGN_EPI = false, bool SP2 = false>
__device__ __forceinline__ void gemm_phase(PG8_LAS unsigned char* lds, const Gemm g, const Sched& S, const Epi& E) {
    int tid_l = threadIdx.x; asm volatile("" : "+v"(tid_l));
    const int tid = tid_l, wid = __builtin_amdgcn_readfirstlane(tid >> 6), lane = tid & 63, wr = wid >> 2, wc = wid & 3, fr = lane & 15, fq = lane >> 4;
    const int K = g.K, nt = K / BK;
    unsigned voffA[2], voffB[2];
#pragma unroll
    for (int i = 0; i < 2; ++i) { int R, C; stage_rc(tid * 16 + i * 8192, R, C); const int Rb = Epi::PERM ? ((R & ~31) + perm32(R & 31)) : R;
        voffA[i] = (unsigned)(R * K + C) * 2u; voffB[i] = (unsigned)(Rb * K + C) * 2u; }
    const size_t kstep = (size_t)(BK * 2);
    const size_t hstep = (size_t)HALF * K * 2;
    const size_t tstep = 2 * hstep;
    const unsigned ldsw = (unsigned)wid * 1024u;
    const int aoff = lds_byte(wr * 64 + fr, fq * 8), boff = lds_byte(wc * 32 + fr, fq * 8);
#define PG8_SA(b, h) (((b) * 2 + (h)) * HTB)
#define PG8_SB(b, h) ((4 + (b) * 2 + (h)) * HTB)
#define PG8_STAGE(bufoff, gbase, voff) do { _Pragma("unroll") for (int _i = 0; _i < 2; ++_i) \
        __builtin_amdgcn_global_load_lds((const unsigned*)((const char*)(gbase) + (voff)[_i]), (PG8_LAS unsigned*)(lds + (bufoff) + ldsw + _i * 8192), 16, 0, 0); } while (0)
#define PG8_LDA(dst, b, h) do { _Pragma("unroll") for (int m = 0; m < 4; ++m) _Pragma("unroll") for (int k = 0; k < 2; ++k) dst[m][k] = *(const PG8_LAS bf16x8*)(lds + PG8_SA(b, h) + aoff + m * 2048 + k * 1024); } while (0)
#define PG8_LDB(dst, b, h) do { _Pragma("unroll") for (int n = 0; n < 2; ++n) _Pragma("unroll") for (int k = 0; k < 2; ++k) dst[n][k] = *(const PG8_LAS bf16x8*)(lds + PG8_SB(b, h) + boff + n * 2048 + k * 1024); } while (0)
#define PG8_MMA(ai, bj, At, Bt) do { __builtin_amdgcn_s_setprio(1); _Pragma("unroll") for (int m = 0; m < 4; ++m) _Pragma("unroll") for (int n = 0; n < 2; ++n) _Pragma("unroll") for (int k = 0; k < 2; ++k) \
        acc[ai][bj][m][n] = __builtin_amdgcn_mfma_f32_16x16x32_bf16(Bt[n][k], At[m][k], acc[ai][bj][m][n], 0, 0, 0); __builtin_amdgcn_s_setprio(0); } while (0)
#define PG8_WAIT_V(n) asm volatile("s_waitcnt vmcnt(" #n ")" ::: "memory")
#define PG8_WAIT_L(n) asm volatile("s_waitcnt lgkmcnt(" #n ")" ::: "memory")
#define PG8_BAR __builtin_amdgcn_s_barrier()
#define PG8_SCHED __builtin_amdgcn_sched_barrier(0)
    Unit cur, nxt; int ui = 0;
    if (!S.next(0, cur)) return;
    f32x4 acc[2][2][4][2];
#pragma unroll
    for (int a = 0; a < 2; ++a)
#pragma unroll
        for (int b = 0; b < 2; ++b)
#pragma unroll
            for (int m = 0; m < 4; ++m)
#pragma unroll
                for (int n = 0; n < 2; ++n) acc[a][b][m][n] = (f32x4){0.f, 0.f, 0.f, 0.f};
    bf16x8 At[4][2], B0[2][2], B1[2][2];
    const char* cA = (const char*)g.A + (size_t)cur.pm * tstep; const char* cB = (const char*)g.Bt + (size_t)cur.pn * tstep;
    S.a_ready(cur);
    if constexpr (SP2) {
        PG8_STAGE(PG8_SB(0, 0), cB, voffB); PG8_STAGE(PG8_SB(0, 1), cB + hstep, voffB); PG8_STAGE(PG8_SA(0, 0), cA, voffA); PG8_STAGE(PG8_SA(0, 1), cA + hstep, voffA);
        if (wr == 1) PG8_BAR;
        PG8_WAIT_V(2); PG8_BAR;
        PG8_STAGE(PG8_SB(1, 0), cB + kstep, voffB); PG8_STAGE(PG8_SA(1, 0), cA + kstep, voffA); PG8_STAGE(PG8_SB(1, 1), cB + hstep + kstep, voffB);
        PG8_WAIT_V(6); PG8_BAR;
    } else {
        PG8_STAGE(PG8_SB(0, 0), cB, voffB); PG8_STAGE(PG8_SA(0, 0), cA, voffA); PG8_STAGE(PG8_SB(0, 1), cB + hstep, voffB); PG8_STAGE(PG8_SA(0, 1), cA + hstep, voffA);
        if (wr == 1) PG8_BAR;
        PG8_WAIT_V(4); PG8_BAR;
        PG8_STAGE(PG8_SB(1, 0), cB + kstep, voffB); PG8_STAGE(PG8_SA(1, 0), cA + kstep, voffA); PG8_STAGE(PG8_SB(1, 1), cB + hstep + kstep, voffB);
        PG8_WAIT_V(6); PG8_BAR;
    }
    for (;;) {
        const bool has_next = S.next(ui + 1, nxt);
        const char* nA = has_next ? (const char*)g.A + (size_t)nxt.pm * tstep : cA; const char* nB = has_next ? (const char*)g.Bt + (size_t)nxt.pn * tstep : cB;
        for (int t = 0; t < nt; t += 2) {
            const bool last = (t == nt - 2);
            const char* a1 = cA + (size_t)(t + 1) * kstep;
            const char* a2 = last ? nA : cA + (size_t)(t + 2) * kstep; const char* b2 = last ? nB : cB + (size_t)(t + 2) * kstep;
            const char* a3 = a2 + kstep; const char* b3 = b2 + kstep;
            if (last && has_next) S.a_ready(nxt);
            if constexpr (SP2) {
            PG8_LDB(B0, 0, 0); PG8_LDB(B1, 0, 1); PG8_SCHED; PG8_LDA(At, 0, 0); PG8_STAGE(PG8_SA(1, 1), a1 + hstep, voffA);
            PG8_WAIT_V(8); PG8_WAIT_L(0); PG8_BAR; PG8_MMA(0, 0, At, B0); PG8_MMA(0, 1, At, B1); PG8_BAR; PG8_SCHED;
            PG8_LDA(At, 0, 1); PG8_STAGE(PG8_SB(0, 0), b2, voffB); PG8_STAGE(PG8_SB(0, 1), b2 + hstep, voffB); PG8_STAGE(PG8_SA(0, 0), a2, voffA);
            PG8_WAIT_V(8); PG8_WAIT_L(0); PG8_BAR; PG8_MMA(1, 0, At, B0); PG8_MMA(1, 1, At, B1); PG8_BAR; PG8_SCHED;
            PG8_LDB(B0, 1, 0); PG8_LDB(B1, 1, 1); PG8_SCHED; PG8_LDA(At, 1, 0); PG8_STAGE(PG8_SA(0, 1), a2 + hstep, voffA);
            PG8_WAIT_V(8); PG8_WAIT_L(0); PG8_BAR; PG8_MMA(0, 0, At, B0); PG8_MMA(0, 1, At, B1); PG8_BAR; PG8_SCHED;
            PG8_LDA(At, 1, 1); PG8_STAGE(PG8_SB(1, 0), b3, voffB); PG8_STAGE(PG8_SB(1, 1), b3 + hstep, voffB); PG8_STAGE(PG8_SA(1, 0), a3, voffA);
            PG8_WAIT_V(8); PG8_WAIT_L(0); PG8_BAR; PG8_MMA(1, 0, At, B0); PG8_MMA(1, 1, At, B1); PG8_BAR; PG8_SCHED;
            } else {
            PG8_LDB(B0, 0, 0); PG8_SCHED; PG8_LDA(At, 0, 0); PG8_STAGE(PG8_SA(1, 1), a1 + hstep, voffA);
            PG8_WAIT_L(8); PG8_BAR; PG8_WAIT_L(0); PG8_MMA(0, 0, At, B0); PG8_BAR; PG8_SCHED;
            PG8_LDB(B1, 0, 1); PG8_STAGE(PG8_SB(0, 0), b2, voffB);
            PG8_BAR; PG8_WAIT_L(0); PG8_MMA(0, 1, At, B1); PG8_BAR;
            PG8_LDA(At, 0, 1); PG8_STAGE(PG8_SA(0, 0), a2, voffA);
            PG8_BAR; PG8_WAIT_L(0); PG8_MMA(1, 0, At, B0); PG8_BAR; PG8_SCHED;
            PG8_STAGE(PG8_SB(0, 1), b2 + hstep, voffB);
            PG8_WAIT_V(6); PG8_BAR; PG8_MMA(1, 1, At, B1); PG8_BAR;
            PG8_LDB(B0, 1, 0); PG8_SCHED; PG8_LDA(At, 1, 0); PG8_STAGE(PG8_SA(0, 1), a2 + hstep, voffA);
            PG8_WAIT_L(8); PG8_BAR; PG8_WAIT_L(0); PG8_MMA(0, 0, At, B0); PG8_BAR; PG8_SCHED;
            PG8_LDB(B1, 1, 1); PG8_STAGE(PG8_SB(1, 0), b3, voffB);
            PG8_BAR; PG8_WAIT_L(0); PG8_MMA(0, 1, At, B1); PG8_BAR;
            PG8_LDA(At, 1, 1); PG8_STAGE(PG8_SA(1, 0), a3, voffA);
            PG8_BAR; PG8_WAIT_L(0); PG8_MMA(1, 0, At, B0); PG8_BAR; PG8_SCHED;
            PG8_STAGE(PG8_SB(1, 1), b3 + hstep, voffB);
            PG8_WAIT_V(6); PG8_BAR; PG8_MMA(1, 1, At, B1); PG8_BAR;
            }
        }
        if constexpr (ALIGN_EPI) { if (wr == 0) PG8_BAR; }
        if constexpr (!Epi::AFTER_DRAIN) { E(acc, cur, wr, wc, fr, fq); S.done(cur); }
        if (!has_next) break;
#pragma unroll
        for (int a = 0; a < 2; ++a)
#pragma unroll
            for (int b = 0; b < 2; ++b)
#pragma unroll
                for (int m = 0; m < 4; ++m)
#pragma unroll
                    for (int n = 0; n < 2; ++n) acc[a][b][m][n] = (f32x4){0.f, 0.f, 0.f, 0.f};
        cur = nxt; cA = nA; cB = nB; ++ui;
        if constexpr (ALIGN_EPI) { if (wr == 1) PG8_BAR; }
    }
    PG8_WAIT_V(0);
    if constexpr (!ALIGN_EPI) { if (wr == 0) PG8_BAR; }
    PG8_BAR;
    if constexpr (Epi::AFTER_DRAIN) { E.fused(acc, cur, wr, wc, fr, fq, lds, wid, lane); S.done(cur); }
#undef PG8_SA
#undef PG8_SB
#undef PG8_STAGE
#undef PG8_LDA
#undef PG8_LDB
#undef PG8_MMA
#undef PG8_WAIT_V
#undef PG8_WAIT_L
#undef PG8_BAR
#undef PG8_SCHED
}
}

#define GAS __attribute__((address_space(1)))
#define LAS __attribute__((address_space(3)))
typedef unsigned short bf16;
typedef unsigned v4u __attribute__((ext_vector_type(4)));
typedef unsigned v2u __attribute__((ext_vector_type(2)));
typedef float f32x4 __attribute__((ext_vector_type(4)));
typedef float f32x16 __attribute__((ext_vector_type(16)));
typedef short bf16x8 __attribute__((ext_vector_type(8)));
typedef short s16x4 __attribute__((ext_vector_type(4)));
typedef GAS unsigned gu32;
#define RLX_AGENT __ATOMIC_RELAXED, __HIP_MEMORY_SCOPE_AGENT
#define LDS_WAIT() asm volatile("s_waitcnt lgkmcnt(0)" ::: "memory")
#define VM_WAIT() asm volatile("s_waitcnt vmcnt(0)" ::: "memory")
__device__ __forceinline__ unsigned f2bf(float f) { unsigned u = __builtin_bit_cast(unsigned, f); return (u + 0x7fffu + ((u >> 16) & 1u)) >> 16; }
__device__ __forceinline__ unsigned pk2(float lo, float hi) { return f2bf(lo) | (f2bf(hi) << 16); }
__device__ __forceinline__ float bf2f(unsigned short b) { return __builtin_bit_cast(float, (unsigned)b << 16); }
__device__ __forceinline__ float bflo(unsigned w) { return __builtin_bit_cast(float, w << 16); }
__device__ __forceinline__ float bfhi(unsigned w) { return __builtin_bit_cast(float, w & 0xffff0000u); }
__device__ __forceinline__ float wave_sum(float v) {
#pragma unroll
    for (int o = 1; o < 64; o <<= 1) v += __shfl_xor(v, o);
    return v;
}
__device__ __forceinline__ float wave_max(float v) {
#pragma unroll
    for (int o = 1; o < 64; o <<= 1) v = fmaxf(v, __shfl_xor(v, o));
    return v;
}
__device__ __forceinline__ float log_sigmoid(float x) { return fminf(x, 0.f) - log1pf(expf(-fabsf(x))); }

#define XB_TMO      128
#define XB_XCNT(j)  (256  + 64 * (j))
#define XB_XSUB(j)  (1280 + 64 * (j))
#define XB_XGEN(j)  (2304 + 64 * (j))
#define XB_TOP      3328
#define XB_TOPGEN   3392
#define XCD_BAR_WORDS 3456
#define XB_SPIN_CAP (1u << 18)

__device__ __forceinline__ unsigned xb_ld(unsigned* p)              { return __hip_atomic_load(p, __ATOMIC_RELAXED, __HIP_MEMORY_SCOPE_AGENT); }
__device__ __forceinline__ unsigned xb_add(unsigned* p, unsigned v) { return __hip_atomic_fetch_add(p, v, __ATOMIC_RELAXED, __HIP_MEMORY_SCOPE_AGENT); }
__device__ __forceinline__ unsigned xb_xcc_id() { return (unsigned)__builtin_amdgcn_s_getreg((3 << 11) | 20) & 0xFu; }
#define XB_SPIN(cond, bar) do { unsigned _sp = 0; while (cond) { __builtin_amdgcn_s_sleep(1); \
    if ((++_sp & 255u) == 0u) { if (xb_ld(&(bar)[XB_TMO])) break; if (_sp > XB_SPIN_CAP) { atomicAdd(&(bar)[XB_TMO], 1u); break; } } } } while (0)

struct XcdBarrier {
    unsigned* bar; unsigned x;
    volatile LAS unsigned* st;
};

__device__ __forceinline__ XcdBarrier xcd_barrier_post(unsigned* bar, volatile LAS unsigned* st) {
    XcdBarrier b; b.bar = bar; b.x = xb_xcc_id(); b.st = st;
    if (threadIdx.x == 0) (void)xb_add(&bar[XB_XCNT(b.x)], 1u);
    return b;
}
__device__ __forceinline__ void xcd_barrier_complete(unsigned* bar, unsigned x, unsigned& nloc, unsigned& nx) {
    const unsigned G = gridDim.x * gridDim.y * gridDim.z;
    unsigned sum, cnt, mine, sp = 0u;
    for (;;) {
        sum = 0u; cnt = 0u; mine = 0u;
#pragma unroll
        for (unsigned j = 0; j < 16; ++j) { const unsigned c = xb_ld(&bar[XB_XCNT(j)]); sum += c; cnt += (c > 0u) ? 1u : 0u; mine = (j == x) ? c : mine; }
        if (sum == G) break;
        __builtin_amdgcn_s_sleep(1);
        if ((++sp & 255u) == 0u) { if (xb_ld(&bar[XB_TMO])) break; if (sp > XB_SPIN_CAP) { atomicAdd(&bar[XB_TMO], 1u); break; } }
    }
    nloc = mine > 0u ? mine : 1u; nx = cnt > 0u ? cnt : 1u;
}

__device__ __forceinline__ void xcd_barrier(const XcdBarrier& b) {
    asm volatile("s_waitcnt vmcnt(0)" ::: "memory");
    __syncthreads();
    if (threadIdx.x == 0) {
        unsigned* bar = b.bar;
        __builtin_amdgcn_s_waitcnt(0);
        unsigned nloc = b.st[0], nx = b.st[1];
        if (nloc == 0u) { xcd_barrier_complete(bar, b.x, nloc, nx); b.st[0] = nloc; b.st[1] = nx; }
        const unsigned old = xb_add(&bar[XB_XSUB(b.x)], 1u);
        const unsigned gen = old / nloc;
        if (old + 1u == (gen + 1u) * nloc) {
            __builtin_amdgcn_fence(__ATOMIC_RELEASE, "agent");
            asm volatile("s_waitcnt vmcnt(0)" ::: "memory");
            const unsigned og = xb_add(&bar[XB_TOP], 1u);
            const unsigned tg = og / nx;
            if (og + 1u == (tg + 1u) * nx) xb_add(&bar[XB_TOPGEN], 1u);
            else XB_SPIN(xb_ld(&bar[XB_TOPGEN]) == tg, bar);
            __builtin_amdgcn_fence(__ATOMIC_ACQUIRE, "agent");
            xb_add(&bar[XB_XGEN(b.x)], 1u);
            asm volatile("s_waitcnt vmcnt(0)" ::: "memory");
        } else {
            XB_SPIN(xb_ld(&bar[XB_XGEN(b.x)]) == gen, bar);
            __builtin_amdgcn_fence(__ATOMIC_ACQUIRE, "agent");
            asm volatile("s_waitcnt vmcnt(0)" ::: "memory");
        }
    }
    __syncthreads();
}

constexpr size_t MiB = 1u << 20;
constexpr size_t WS_CTL = 0, CTL_ZERO_BYTES = 1 * MiB;
constexpr size_t WS_ROPE = 1 * MiB;
constexpr size_t WS_BIASA = 3 * MiB;
constexpr size_t WS_CONVW = 3 * MiB + 65536;
constexpr size_t WS_CONVB = WS_CONVW + (size_t)4 * 3 * UPN * 4;
constexpr size_t WS_GATES = 4 * MiB;
constexpr size_t WS_WG = 5 * MiB;
constexpr size_t WS_WAIN = 6 * MiB, WS_WAOUT = 42 * MiB, WS_WMIN = 58 * MiB, WS_WMOUT = 106 * MiB, WS_WUP = 122 * MiB, WS_WDN = 298 * MiB;
constexpr size_t WS_X = 386 * MiB;
constexpr size_t WS_XB = 514 * MiB;
constexpr size_t WS_R1 = 578 * MiB;
constexpr size_t WS_PROJ = WS_R1, WS_HEADS = WS_R1 + 192 * MiB;
constexpr size_t WS_H = 930 * MiB;
constexpr size_t WS_END = 1106 * MiB;
constexpr size_t WS_FOXC = 1106 * MiB;
constexpr size_t WS_NEED = 1108 * MiB;
static_assert(WS_CONVB + (size_t)4 * UPN * 4 <= WS_GATES && WS_WAIN + (size_t)2 * ATT_N * DM * 2 <= WS_WAOUT && WS_WMIN + (size_t)2 * ML_N * DM * 2 <= WS_WMOUT &&
              WS_WUP + (size_t)4 * UPN * DM * 2 <= WS_WDN && WS_WDN + (size_t)4 * DM * DFF * 2 <= WS_X && WS_R1 + (size_t)MTOK * UPN * 2 <= WS_H && WS_H + (size_t)MTOK * DFF * 2 <= WS_END, "ws map");
constexpr int CW_BAR = 4096;
constexpr int BAR_STRIDE = 4096;

constexpr int RING_BYTES = 131072;
constexpr int LDSCTL_OFF = RING_BYTES;
constexpr int LDS_BYTES = 147456;
constexpr int NWAVES = 8, NTHREADS = 512;

enum { MAP_ID = 0, MAP_ATT = 1, MAP_ATTG = 2, MAP_MLG = 3, MAP_UP = 4 };
__device__ __forceinline__ int src_col(int kind, int n) {
    if (kind == MAP_ATT) {
        if (n < 3072) return n;
        if (n < 4352) { const int base = n < 4096 ? 3072 : 4096, sbase = n < 4096 ? 3080 : 4104, r = n - base, hh = r >> 7, p = r & 127; return sbase + hh * 128 + (p >> 1) + ((p & 1) << 6); }
        return 4360 + (n - 4352);
    }
    if (kind == MAP_ATTG) return n < 8 ? 3072 + n : -1;
    if (kind == MAP_MLG) return n < 16 ? 6144 + n : -1;
    if (kind == MAP_UP) { const int tile = n >> 8, w = n & 255; return w < 128 ? tile * 128 + w : DFF + tile * 128 + (w - 128); }
    return n;
}
__device__ __forceinline__ void tr_item(const float* W, int K, int Nsrc, int Nd, bf16* WT, int kind, LAS float* scr, int item, int lane) {
    const int nblk = Nd / 32, kb = item / nblk, nb = item % nblk, k0 = 64 * kb, n0 = 32 * nb;
    const int c = src_col(kind, n0 + (lane & 31));
#pragma unroll 8
    for (int i = 0; i < 32; ++i) { const int kk = 2 * i + (lane >> 5); scr[kk * 33 + (lane & 31)] = c >= 0 ? W[(size_t)(k0 + kk) * Nsrc + c] : 0.f; }
    LDS_WAIT(); asm volatile("" ::: "memory");
    const int ch = lane & 7;
#pragma unroll
    for (int j = 0; j < 4; ++j) { const int n = (lane >> 3) + 8 * j; const LAS float* s = scr + (8 * ch) * 33 + n;
        v4u o; o.x = pk2(s[0 * 33], s[1 * 33]); o.y = pk2(s[2 * 33], s[3 * 33]); o.z = pk2(s[4 * 33], s[5 * 33]); o.w = pk2(s[6 * 33], s[7 * 33]);
        *(GAS v4u*)(WT + (size_t)(n0 + n) * K + k0 + 8 * ch) = o; }
    LDS_WAIT(); asm volatile("" ::: "memory");
}

struct Args { const float* in[16]; float* out; unsigned char* ws; int ph_lo, ph_hi, bar_region, pad; };

__device__ __forceinline__ void p0_prologue(const Args& a, LAS unsigned char* lds, int vcu, int G, int wave, int lane, int tid) {
    unsigned char* ws = a.ws;
    LAS float* scr = (LAS float*)(lds + wave * 16384);
    const int gw = vcu * NWAVES + wave, NGW = G * NWAVES;
    constexpr int KB = DM / 64;
    constexpr int I_AIN = KB * (ATT_N / 32), I_G = KB * 1, I_OUT = KB * (DM / 32), I_MIN = KB * (ML_N / 32), I_UP = KB * (UPN / 32), I_DN = (DFF / 64) * (DM / 32);
    constexpr int NITEMS = 2 * (I_AIN + I_G + I_OUT + I_MIN + I_G + I_OUT) + 4 * (I_UP + I_DN);
    for (int it = gw; it < NITEMS; it += NGW) {
        int r = it;
        if (r < 4 * I_UP) { const int l = r / I_UP; tr_item(a.in[8] + (size_t)l * DM * UPN, DM, UPN, UPN, (bf16*)(ws + WS_WUP) + (size_t)l * UPN * DM, MAP_UP, scr, r % I_UP, lane); continue; } r -= 4 * I_UP;
        if (r < 4 * I_DN) { const int l = r / I_DN; tr_item(a.in[11] + (size_t)l * DFF * DM, DFF, DM, DM, (bf16*)(ws + WS_WDN) + (size_t)l * DM * DFF, MAP_ID, scr, r % I_DN, lane); continue; } r -= 4 * I_DN;
        if (r < 2 * I_AIN) { const int l = r / I_AIN; tr_item(a.in[1] + (size_t)l * DM * ATT_IN, DM, ATT_IN, ATT_N, (bf16*)(ws + WS_WAIN) + (size_t)l * ATT_N * DM, MAP_ATT, scr, r % I_AIN, lane); continue; } r -= 2 * I_AIN;
        if (r < 2 * I_MIN) { const int l = r / I_MIN; tr_item(a.in[5] + (size_t)l * DM * ML_IN, DM, ML_IN, ML_N, (bf16*)(ws + WS_WMIN) + (size_t)l * ML_N * DM, MAP_ID, scr, r % I_MIN, lane); continue; } r -= 2 * I_MIN;
        if (r < 2 * I_OUT) { const int l = r / I_OUT; tr_item(a.in[4] + (size_t)l * DM * DM, DM, DM, DM, (bf16*)(ws + WS_WAOUT) + (size_t)l * DM * DM, MAP_ID, scr, r % I_OUT, lane); continue; } r -= 2 * I_OUT;
        if (r < 2 * I_OUT) { const int l = r / I_OUT; tr_item(a.in[7] + (size_t)l * DM * DM, DM, DM, DM, (bf16*)(ws + WS_WMOUT) + (size_t)l * DM * DM, MAP_ID, scr, r % I_OUT, lane); continue; } r -= 2 * I_OUT;
        if (r < 2 * I_G) { const int l = r / I_G; tr_item(a.in[1] + (size_t)l * DM * ATT_IN, DM, ATT_IN, 32, (bf16*)(ws + WS_WG) + (size_t)l * 32 * DM, MAP_ATTG, scr, r % I_G, lane); continue; } r -= 2 * I_G;
        { const int l = r / I_G; tr_item(a.in[5] + (size_t)l * DM * ML_IN, DM, ML_IN, 32, (bf16*)(ws + WS_WG) + (size_t)(2 + l) * 32 * DM, MAP_MLG, scr, r % I_G, lane); }
    }
    { const float* x = a.in[0]; float* X = (float*)(ws + WS_X); bf16* XB = (bf16*)(ws + WS_XB);
      for (int m = gw; m < MTOK; m += NGW) {
          const GAS f32x4* xr = (const GAS f32x4*)(x + (size_t)m * DM) + lane; GAS f32x4* o = (GAS f32x4*)(X + (size_t)m * DM) + lane; GAS v2u* ob = (GAS v2u*)(XB + (size_t)m * DM) + lane;
#pragma unroll
          for (int j = 0; j < 8; ++j) { const f32x4 v = xr[64 * j]; o[64 * j] = v; v2u w; w.x = pk2(v.x, v.y); w.y = pk2(v.z, v.w); ob[64 * j] = w; } } }
    const int gt = (vcu * NTHREADS) + tid, NGT = G * NTHREADS;
    { float* rope = (float*)(ws + WS_ROPE);
      for (int i = gt; i < 4096 * 64; i += NGT) { const int pos = i >> 6, f = i & 63;
          const float inv = powf(10000.0f, -(float)f * (2.0f / 128.0f)); const float ang = (float)pos * inv;
          double ad = (double)ang; ad -= 6.283185307179586476925 * rint(ad * 0.15915494309189533577);
          const float ar = (float)ad; rope[2 * i] = cosf(ar); rope[2 * i + 1] = sinf(ar); } }
    { float* bA = (float*)(ws + WS_BIASA);
      for (int i = gt; i < 2 * ATT_N; i += NGT) { const int l = i / ATT_N, n = i % ATT_N; bA[i] = a.in[2][(size_t)l * ATT_IN + src_col(MAP_ATT, n)]; } }
    { float* cw = (float*)(ws + WS_CONVW); float* cb = (float*)(ws + WS_CONVB);
      for (int i = gt; i < 4 * 3 * UPN; i += NGT) { const int lj = i / UPN, n = i % UPN; cw[i] = a.in[9][(size_t)lj * UPN + src_col(MAP_UP, n)]; }
      for (int i = gt; i < 4 * UPN; i += NGT) { const int l = i / UPN, n = i % UPN; cb[i] = a.in[10][(size_t)l * UPN + src_col(MAP_UP, n)]; } }
}

__device__ __forceinline__ void gates_phase(const bf16* XB, const bf16* WG, const float* bsrc, int nb, float* GATES, int gw, int NGW, int lane) {
    typedef float f4 __attribute__((ext_vector_type(4)));
    for (int task = gw; task < MTOK / 16; task += NGW) {
        const int m0 = task * 16;
        f4 acc = (f4){0.f, 0.f, 0.f, 0.f};
        const bf16* ap = XB + (size_t)(m0 + (lane & 15)) * DM + 8 * (lane >> 4);
        const bf16* bp = WG + (size_t)(lane & 15) * DM + 8 * (lane >> 4);
#pragma unroll 8
        for (int k0 = 0; k0 < DM; k0 += 32) { const bf16x8 av = *(const bf16x8*)(ap + k0); const bf16x8 bv = *(const bf16x8*)(bp + k0); acc = __builtin_amdgcn_mfma_f32_16x16x32_bf16(av, bv, acc, 0, 0, 0); }
        const int g = lane & 15; const float bias = g < nb ? bsrc[g] : 0.f;
#pragma unroll
        for (int r = 0; r < 4; ++r) GATES[(size_t)(m0 + (lane >> 4) * 4 + r) * 16 + g] = acc[r] + bias;
    }
}

__device__ __forceinline__ void ln_phase(const float* X, float* Xo, bf16* XBo, const float* g, const float* b, int gw, int NGW, int lane) {
    f32x4 gv[8], bv[8];
#pragma unroll
    for (int j = 0; j < 8; ++j) { gv[j] = ((const f32x4*)g)[lane + 64 * j]; bv[j] = ((const f32x4*)b)[lane + 64 * j]; }
    for (int m = gw; m < MTOK; m += NGW) {
        const GAS f32x4* xr = (const GAS f32x4*)(X + (size_t)m * DM) + lane;
        f32x4 v[8]; float s = 0.f;
#pragma unroll
        for (int j = 0; j < 8; ++j) { v[j] = xr[64 * j]; s += (v[j].x + v[j].y) + (v[j].z + v[j].w); }
        const float mean = wave_sum(s) * (1.f / DM); float s2 = 0.f;
#pragma unroll
        for (int j = 0; j < 8; ++j) { v[j] = v[j] - mean; s2 += (v[j].x * v[j].x + v[j].y * v[j].y) + (v[j].z * v[j].z + v[j].w * v[j].w); }
        const float rstd = 1.f / sqrtf(wave_sum(s2) * (1.f / DM) + LN_EPS);
        GAS f32x4* o = (GAS f32x4*)(Xo + (size_t)m * DM) + lane;
#pragma unroll
        for (int j = 0; j < 8; ++j) { v[j] = v[j] * rstd * gv[j] + bv[j]; o[64 * j] = v[j]; }
        if (XBo) { GAS v2u* ob = (GAS v2u*)(XBo + (size_t)m * DM) + lane;
#pragma unroll
            for (int j = 0; j < 8; ++j) { v2u w; w.x = pk2(v[j].x, v[j].y); w.y = pk2(v[j].z, v[j].w); ob[64 * j] = w; } }
    }
}

__device__ __forceinline__ void conv_phase(const bf16* U, bf16* H, const float* cw  , const float* cb  , int gt, int NGT) {
    constexpr int RS = 16, NSTRIP = MTOK / RS, NCG = (UPN / 256) * 16;
    for (int it = gt; it < NSTRIP * NCG; it += NGT) {
        const int strip = it / NCG, cg = it % NCG, tile = cg >> 4, g8 = cg & 15;
        const int pc = tile * 256 + g8 * 8;
        const int t0 = strip * RS;
        float wg[3][8], wv[3][8], bg[8], bvv[8];
#pragma unroll
        for (int j = 0; j < 3; ++j) { const f32x4 a0 = *(const f32x4*)(cw + (size_t)j * UPN + pc), a1 = *(const f32x4*)(cw + (size_t)j * UPN + pc + 4), c0 = *(const f32x4*)(cw + (size_t)j * UPN + pc + 128), c1 = *(const f32x4*)(cw + (size_t)j * UPN + pc + 132);
#pragma unroll
            for (int e = 0; e < 4; ++e) { wg[j][e] = a0[e]; wg[j][4 + e] = a1[e]; wv[j][e] = c0[e]; wv[j][4 + e] = c1[e]; } }
        { const f32x4 a0 = *(const f32x4*)(cb + pc), a1 = *(const f32x4*)(cb + pc + 4), c0 = *(const f32x4*)(cb + pc + 128), c1 = *(const f32x4*)(cb + pc + 132);
#pragma unroll
          for (int e = 0; e < 4; ++e) { bg[e] = a0[e]; bg[4 + e] = a1[e]; bvv[e] = c0[e]; bvv[4 + e] = c1[e]; } }
        float g2[8], g1[8], v2[8], v1[8];
        const bool first = (t0 & (SEQ - 1)) == 0;
#pragma unroll
        for (int e = 0; e < 8; ++e) { g2[e] = 0.f; g1[e] = 0.f; v2[e] = 0.f; v1[e] = 0.f; }
        if (!first) {
            const v4u a = *(const v4u*)(U + (size_t)(t0 - 2) * UPN + pc), b = *(const v4u*)(U + (size_t)(t0 - 1) * UPN + pc), c = *(const v4u*)(U + (size_t)(t0 - 2) * UPN + pc + 128), d = *(const v4u*)(U + (size_t)(t0 - 1) * UPN + pc + 128);
#pragma unroll
            for (int e = 0; e < 4; ++e) { g2[2 * e] = bflo(a[e]); g2[2 * e + 1] = bfhi(a[e]); g1[2 * e] = bflo(b[e]); g1[2 * e + 1] = bfhi(b[e]);
                                          v2[2 * e] = bflo(c[e]); v2[2 * e + 1] = bfhi(c[e]); v1[2 * e] = bflo(d[e]); v1[2 * e + 1] = bfhi(d[e]); }
        }
#pragma unroll 4
        for (int r = 0; r < RS; ++r) {
            const int t = t0 + r;
            const v4u a = *(const v4u*)(U + (size_t)t * UPN + pc), c = *(const v4u*)(U + (size_t)t * UPN + pc + 128);
            float g0[8], v0[8], o[8];
#pragma unroll
            for (int e = 0; e < 4; ++e) { g0[2 * e] = bflo(a[e]); g0[2 * e + 1] = bfhi(a[e]); v0[2 * e] = bflo(c[e]); v0[2 * e + 1] = bfhi(c[e]); }
#pragma unroll
            for (int e = 0; e < 8; ++e) {
                const float cgt = bg[e] + wg[0][e] * g2[e] + wg[1][e] * g1[e] + wg[2][e] * g0[e];
                const float cvl = bvv[e] + wv[0][e] * v2[e] + wv[1][e] * v1[e] + wv[2][e] * v0[e];
                o[e] = cgt / (1.f + __expf(-cgt)) * cvl;
                g2[e] = g1[e]; g1[e] = g0[e]; v2[e] = v1[e]; v1[e] = v0[e];
            }
            v4u w; w.x = pk2(o[0], o[1]); w.y = pk2(o[2], o[3]); w.z = pk2(o[4], o[5]); w.w = pk2(o[6], o[7]);
            *(v4u*)(H + (size_t)t * DFF + tile * 128 + g8 * 8) = w;
        }
    }
}

#ifndef MIXER_PHASE
#define MIXER_PHASE
#endif

__global__ void __launch_bounds__(NTHREADS, 2) mega(Args a) {
    extern __shared__ __attribute__((aligned(16))) unsigned char lds_raw[];
    LAS unsigned char* lds = (LAS unsigned char*)lds_raw;
    const int tid = threadIdx.x, lane = tid & 63, wave = __builtin_amdgcn_readfirstlane(tid >> 6);
    const int G = gridDim.x, bx = blockIdx.x;
    const int vcu = (G % 8 == 0) ? (bx % 8) * (G / 8) + bx / 8 : bx;
    for (int u = tid; u < (LDS_BYTES - LDSCTL_OFF) / 4; u += NTHREADS) ((LAS unsigned*)(lds + LDSCTL_OFF))[u] = 0u;
    __syncthreads();
    unsigned char* ws = a.ws;
    gu32* ctl = (gu32*)(ws + WS_CTL);
    volatile LAS unsigned* MISC = (volatile LAS unsigned*)(lds + LDSCTL_OFF);
    XcdBarrier bar = xcd_barrier_post((unsigned*)ctl + CW_BAR + a.bar_region * BAR_STRIDE, MISC + 8);
    const int lo = a.ph_lo, hi = a.ph_hi;
#define IN(k) (lo <= (k) && (k) < hi)
#define SEAM(k) do { if (IN(k) && IN((k) + 1)) xcd_barrier(bar); } while (0)
    float* X = (float*)(ws + WS_X); bf16* XB = (bf16*)(ws + WS_XB); bf16* PROJ = (bf16*)(ws + WS_PROJ); bf16* HEADS = (bf16*)(ws + WS_HEADS);
    bf16* UB = (bf16*)(ws + WS_R1); bf16* HB = (bf16*)(ws + WS_H); float* GATES = (float*)(ws + WS_GATES);

    if (IN(0)) p0_prologue(a, lds, vcu, G, wave, lane, tid);
    SEAM(0);
    for (int layer = 0; layer < DEPTH; ++layer) {
        const int j = layer >> 1, odd = layer & 1, pb = 1 + layer * 8;
        int tl = threadIdx.x; asm volatile("" : "+v"(tl));
        const int lane = tl & 63, gw = vcu * NWAVES + wave, NGW = G * NWAVES, gt = vcu * NTHREADS + tl, NGT = G * NTHREADS;
        if (IN(pb)) {
            const bf16* WG = (const bf16*)(ws + WS_WG) + (size_t)(odd ? 2 + j : j) * 32 * DM;
            gates_phase(XB, WG, odd ? a.in[6] + (size_t)j * ML_IN + 6144 : a.in[2] + (size_t)j * ATT_IN + 3072, odd ? 16 : 8, GATES, gw, NGW, lane);
            const int N = odd ? ML_N : ATT_N;
            pg8::Gemm g{XB, odd ? (const bf16*)(ws + WS_WMIN) + (size_t)j * ML_N * DM : (const bf16*)(ws + WS_WAIN) + (size_t)j * ATT_N * DM, MTOK, N, DM};
            pg8::StaticOrder S; S.init(MTOK, N, G, bx);
            pg8::EpiProj E{PROJ, N, odd ? a.in[6] + (size_t)j * ML_IN : (const float*)(ws + WS_BIASA) + (size_t)j * ATT_N, odd ? 0 : A_SQ / 256, odd ? 0 : A_SV / 256, (const float*)(ws + WS_ROPE)};
            pg8::gemm_phase<pg8::EpiProj, pg8::StaticOrder, true, true>(lds, g, S, E);
        }
        SEAM(pb);
        if (IN(pb + 1)) {
            MIXER_PHASE
        }
        SEAM(pb + 1);
        if (IN(pb + 2)) {
            pg8::Gemm g{HEADS, odd ? (const bf16*)(ws + WS_WMOUT) + (size_t)j * DM * DM : (const bf16*)(ws + WS_WAOUT) + (size_t)j * DM * DM, MTOK, DM, DM};
            pg8::StaticOrder S; S.init(MTOK, DM, G, bx);
            pg8::EpiResid E{X, DM, DN_ALPHA};
            pg8::gemm_phase<pg8::EpiResid, pg8::StaticOrder, true, true>(lds, g, S, E);
        }
        SEAM(pb + 2);
        if (IN(pb + 3)) ln_phase(X, X, XB, a.in[12] + (size_t)layer * DM, a.in[13] + (size_t)layer * DM, gw, NGW, lane);
        SEAM(pb + 3);
        if (IN(pb + 4)) {
            pg8::Gemm g{XB, (const bf16*)(ws + WS_WUP) + (size_t)layer * UPN * DM, MTOK, UPN, DM};
            pg8::StaticOrder S; S.init(MTOK, UPN, G, bx);
            pg8::EpiStoreBf16 E{UB, UPN};
            pg8::gemm_phase<pg8::EpiStoreBf16, pg8::StaticOrder, true, true>(lds, g, S, E);
        }
        SEAM(pb + 4);
        if (IN(pb + 5)) conv_phase(UB, HB, (const float*)(ws + WS_CONVW) + (size_t)layer * 3 * UPN, (const float*)(ws + WS_CONVB) + (size_t)layer * UPN, gt, NGT);
        SEAM(pb + 5);
        if (IN(pb + 6)) {
            pg8::Gemm g{HB, (const bf16*)(ws + WS_WDN) + (size_t)layer * DM * DFF, MTOK, DM, DFF};
            pg8::StaticOrder S; S.init(MTOK, DM, G, bx);
            pg8::EpiResid E{X, DM, DN_ALPHA};
            pg8::gemm_phase<pg8::EpiResid, pg8::StaticOrder, true, true>(lds, g, S, E);
        }
        SEAM(pb + 6);
        if (IN(pb + 7)) { const bool lastl = layer == DEPTH - 1; ln_phase(X, lastl ? a.out : X, lastl ? (bf16*)nullptr : XB, a.in[14] + (size_t)layer * DM, a.in[15] + (size_t)layer * DM, gw, NGW, lane); }
        SEAM(pb + 7);
    }
#undef IN
#undef SEAM
}


#if USE_NAIVE
__global__ void naive_fox_c(const float* GATES, float* C) {
    const int i = blockIdx.x * blockDim.x + threadIdx.x; if (i >= NBATCH * FOXH) return;
    const int b = i / FOXH, h = i % FOXH; double acc = 0.0;
    for (int t = 0; t < SEQ; ++t) { acc += (double)log_sigmoid(GATES[(size_t)(b * SEQ + t) * 16 + h]); C[(size_t)i * SEQ + t] = (float)acc; }
}
__global__ __launch_bounds__(64) void naive_attn(const bf16* PROJ, const float* C, const float* sinks, bf16* HEADS) {
    __shared__ float lg[SEQ];
    const int lane = threadIdx.x, id = blockIdx.x;
    const int t = id % SEQ, hd = (id / SEQ) % 16, b = id / (SEQ * 16);
    const bool fox = hd < 8;
    const int qc = fox ? A_FQ + hd * 128 : A_SQ + (hd - 8) * 128, kc = fox ? A_FK + hd * 128 : A_SK + ((hd - 8) / 4) * 128, vc = fox ? A_FV + hd * 128 : A_SV + ((hd - 8) / 4) * 128;
    const bf16* qp = PROJ + (size_t)(b * SEQ + t) * ATT_N + qc;
    v4u q[16];
#pragma unroll
    for (int i = 0; i < 16; ++i) q[i] = *(const v4u*)(qp + 8 * i);
    const int lo = fox ? 0 : (t - (SWAW - 1) > 0 ? t - (SWAW - 1) : 0);
    const float ct = fox ? C[(size_t)(b * FOXH + hd) * SEQ + t] : 0.f;
    float mx = -3.0e38f;
    for (int s = lo + lane; s <= t; s += 64) {
        const bf16* kp = PROJ + (size_t)(b * SEQ + s) * ATT_N + kc; float dot = 0.f;
#pragma unroll
        for (int i = 0; i < 16; ++i) { const v4u kv = *(const v4u*)(kp + 8 * i);
#pragma unroll
            for (int e = 0; e < 4; ++e) dot += bflo(q[i][e]) * bflo(kv[e]) + bfhi(q[i][e]) * bfhi(kv[e]); }
        float lgt = dot * 0.08838834764831845f; if (fox) lgt += ct - C[(size_t)(b * FOXH + hd) * SEQ + s];
        lg[s - lo] = lgt; mx = fmaxf(mx, lgt);
    }
    mx = wave_max(mx);
    const float sink = fox ? 0.f : sinks[hd - 8];
    if (!fox) mx = fmaxf(mx, sink);
    float sum = 0.f;
    for (int s = lo + lane; s <= t; s += 64) { const float p = expf(lg[s - lo] - mx); lg[s - lo] = p; sum += p; }
    sum = wave_sum(sum); if (!fox) sum += expf(sink - mx);
    __syncthreads();
    float a0 = 0.f, a1 = 0.f;
    for (int s = lo; s <= t; ++s) { const float p = lg[s - lo]; const unsigned w = *(const unsigned*)(PROJ + (size_t)(b * SEQ + s) * ATT_N + vc + 2 * lane); a0 += p * bflo(w); a1 += p * bfhi(w); }
    const float inv = 1.f / sum;
    *(unsigned*)(HEADS + (size_t)(b * SEQ + t) * DM + hd * 128 + 2 * lane) = pk2(a0 * inv, a1 * inv);
}
__global__ __launch_bounds__(320) void naive_mlstm(const bf16* PROJ, const float* GATES, bf16* HEADS) {
    __shared__ float sk[128], sq[128], sdot[1];
    const int b = blockIdx.x / MLH, h = blockIdx.x % MLH, tid = threadIdx.x;
    float Cr[128];
#pragma unroll
    for (int d = 0; d < 128; ++d) Cr[d] = 0.f;
    float m = 0.f;
    for (int t = 0; t < SEQ; ++t) {
        const size_t row = (size_t)(b * SEQ + t);
        if (tid < 128) sk[tid] = bf2f(PROJ[row * ML_N + L_K + h * 128 + tid]) * 0.08838834764831845f;
        else if (tid < 256) sq[tid - 128] = bf2f(PROJ[row * ML_N + L_Q + h * 128 + tid - 128]);
        const float ip = GATES[row * 16 + h], fp = GATES[row * 16 + 8 + h];
        const float lf = log_sigmoid(fp), mn = fmaxf(lf + m, ip), fC = expf(lf + m - mn), iw = expf(ip - mn); m = mn;
        const float vv = tid < 256 ? bf2f(PROJ[row * ML_N + L_V + h * 256 + tid]) : 1.0f;
        __syncthreads();
        float num = 0.f; const float iv = iw * vv;
#pragma unroll
        for (int d = 0; d < 128; ++d) { Cr[d] = fC * Cr[d] + iv * sk[d]; num += Cr[d] * sq[d]; }
        if (tid == 256) sdot[0] = num;
        __syncthreads();
        if (tid < 256) { const float den = fmaxf(fabsf(sdot[0]), expf(-m)); const float hh = num / den; const float o = bf2f(PROJ[row * ML_N + L_O + h * 256 + tid]);
            HEADS[row * DM + h * 256 + tid] = (bf16)f2bf(hh / (1.f + expf(-o))); }
    }
}
#endif


static void launch_mega(Args a, int lo, int hi, int region, int grid, hipStream_t stream) {
    a.ph_lo = lo; a.ph_hi = hi; a.bar_region = region; a.pad = 0;
    hipLaunchKernelGGL(mega, dim3(grid), dim3(NTHREADS), LDS_BYTES, stream, a);
    const hipError_t le = hipPeekAtLastError();
    if (le != hipSuccess) fprintf(stderr, "kernel_launch: mega[%d,%d) failed: %s\n", lo, hi, hipGetErrorName(le));
}
extern "C" void kernel_launch(void* const* d_in, const int* in_sizes, int n_in, void* d_out, int out_size, void* d_ws, size_t ws_size, hipStream_t stream) {
    static int grid = 0;
    if (grid == 0) {
        if (n_in != 16 || in_sizes[0] != MTOK * DM || out_size != MTOK * DM || ws_size < WS_NEED) {
            fprintf(stderr, "kernel_launch: unexpected shapes (n_in %d, in0 %d, out %d, ws %zu < %zu); nothing launched\n", n_in, n_in > 0 ? in_sizes[0] : -1, out_size, ws_size, (size_t)WS_NEED); grid = -1; return; }
        int dev = 0, cus = 0, per_cu = 0;
        if (hipGetDevice(&dev) != hipSuccess || hipDeviceGetAttribute(&cus, hipDeviceAttributeMultiprocessorCount, dev) != hipSuccess) { fprintf(stderr, "kernel_launch: device query failed\n"); grid = -1; return; }
        if (hipFuncSetAttribute((const void*)mega, hipFuncAttributeMaxDynamicSharedMemorySize, LDS_BYTES) != hipSuccess) { fprintf(stderr, "kernel_launch: hipFuncSetAttribute failed\n"); grid = -1; return; }
        if (hipOccupancyMaxActiveBlocksPerMultiprocessor(&per_cu, (const void*)mega, NTHREADS, LDS_BYTES) != hipSuccess || per_cu < 1)
            fprintf(stderr, "kernel_launch: note: occupancy query reports %d workgroups per CU\n", per_cu);
        (void)hipGetLastError();
        grid = cus;
    }
    if (grid < 0) return;
    if (hipMemsetAsync((char*)d_ws + WS_CTL, 0, CTL_ZERO_BYTES, stream) != hipSuccess) { fprintf(stderr, "kernel_launch: memset failed\n"); return; }
    Args a{};
    for (int i = 0; i < 16; ++i) a.in[i] = (const float*)d_in[i];
    a.out = (float*)d_out; a.ws = (unsigned char*)d_ws;
#if USE_NAIVE
    unsigned char* ws = (unsigned char*)d_ws;
    const bf16* PROJ = (const bf16*)(ws + WS_PROJ); bf16* HEADS = (bf16*)(ws + WS_HEADS); const float* GATES = (const float*)(ws + WS_GATES); float* FOXC = (float*)(ws + WS_FOXC);
    int region = 0;
    launch_mega(a, 0, 2, region++, grid, stream);
    for (int layer = 0; layer < DEPTH; ++layer) {
        const int pb = 1 + layer * 8, j = layer >> 1;
        if ((layer & 1) == 0) {
            hipLaunchKernelGGL(naive_fox_c, dim3(1), dim3(64), 0, stream, GATES, FOXC);
            hipLaunchKernelGGL(naive_attn, dim3(NBATCH * 16 * SEQ), dim3(64), 0, stream, PROJ, (const float*)FOXC, a.in[3] + (size_t)j * SWAQ, HEADS);
        } else {
            hipLaunchKernelGGL(naive_mlstm, dim3(NBATCH * MLH), dim3(320), 0, stream, PROJ, GATES, HEADS);
        }
        launch_mega(a, pb + 2, layer == DEPTH - 1 ? pb + 8 : pb + 9, region++, grid, stream);
    }
#else
    launch_mega(a, 0, 1 + DEPTH * 8, 0, grid, stream);
#endif
}
```

```cpp
#include <hip/hip_runtime.h>
#include <cstdio>
#include <cstdint>

constexpr int DM = 2048, NBATCH = 4, SEQ = 4096, MTOK = NBATCH * SEQ, DEPTH = 4;
constexpr int HD = 128, FOXH = 8, SWAQ = 8, SWAKV = 2, SWAW = 128;
constexpr int ATT_IN = 4616, ATT_N = 4608;
constexpr int ML_IN = 6160, ML_N = 6144;
constexpr int MLH = 8, MLDK = 128, MLDV = 256, MLCH = 64;
constexpr int DFF = 5632, UPN = 2 * DFF;
constexpr float LN_EPS = 1e-5f;
constexpr float DN_ALPHA = 1.6817928305074290f;
constexpr int A_FQ = 0, A_FK = 1024, A_FV = 2048, A_SQ = 3072, A_SK = 4096, A_SV = 4352;
constexpr int L_Q = 0, L_K = 1024, L_V = 2048, L_O = 4096;

#define NAIVE_MLSTM 1
#ifndef NAIVE_ATTN
#define NAIVE_ATTN 0
#endif
#ifndef NAIVE_MLSTM
#define NAIVE_MLSTM 0
#endif
namespace pg8 {
#define PG8_LAS __attribute__((address_space(3)))
typedef unsigned short bf16_t;
typedef short bf16x8 __attribute__((ext_vector_type(8)));
typedef float f32x4 __attribute__((ext_vector_type(4)));
typedef unsigned u32x4 __attribute__((ext_vector_type(4)));
constexpr int BM = 256, BK = 64, HALF = 128, HTB = HALF * BK * 2  , STAGE_BYTES = 8 * HTB, NXCD = 8, WGM = 8;

__host__ __device__ __forceinline__ int lds_byte(int r, int c) { const int st = (r >> 4) * 2 + (c >> 5), rr = r & 15, cc = c & 31, ob = rr * 64 + cc * 2; return st * 1024 + (ob ^ (((ob >> 9) & 1) << 5)); }
__host__ __device__ __forceinline__ void stage_rc(int b, int& R, int& C) { const int st = b / 1024, sb = b % 1024, swz = sb ^ (((sb >> 9) & 1) << 5); R = (st >> 1) * 16 + swz / 64; C = (st & 1) * 32 + (swz % 64) / 2; }
__host__ __device__ __forceinline__ int perm32(int rho) { const int n = rho >> 4, i = rho & 15; return 8 * (i >> 2) + 4 * n + (i & 3); }

struct Unit { int pm, pn; };
struct Gemm { const bf16_t* A; const bf16_t* Bt; int M, N, K; };

struct StaticOrder {
    int nM, nN, nwg, G, c;
    __host__ __device__ void init(int M, int N, int G_, int c_) { nM = M / BM; nN = N / BM; nwg = nM * nN; G = G_; c = c_; }
    __host__ __device__ bool next(int i, Unit& u) const {
        const long L = (long)i * G + c; if (L >= nwg) return false;
        int wgid = (int)L; { const int q = nwg / NXCD, r = nwg % NXCD, xcd = wgid % NXCD, off = wgid / NXCD; wgid = (xcd < r ? xcd * (q + 1) : r * (q + 1) + (xcd - r) * q) + off; }
        const int nig = WGM * nN, gid = wgid / nig, fm = gid * WGM, gsz = (nM - fm) < WGM ? (nM - fm) : WGM;
        u.pm = fm + ((wgid % nig) % gsz); u.pn = (wgid % nig) / gsz; return true;
    }
    __device__ __forceinline__ void a_ready(const Unit&) const {}
    __device__ __forceinline__ void done(const Unit&) const {}
};
__device__ __forceinline__ unsigned cvt_pk_bf16(float lo, float hi) { unsigned r; asm volatile("v_cvt_pk_bf16_f32 %0, %1, %2" : "=v"(r) : "v"(lo), "v"(hi)); return r; }
typedef float f32x2 __attribute__((ext_vector_type(2)));
typedef unsigned u32x2 __attribute__((ext_vector_type(2)));
struct EpiStoreBf16 {
    static constexpr bool PERM = true, AFTER_DRAIN = false;
    bf16_t* O; int ldc;
    __device__ __forceinline__ void operator()(const f32x4 (&acc)[2][2][4][2], const Unit& u, int wr, int wc, int fr, int fq) const {
        const int row0 = u.pm * BM + wr * 64 + fr, col0 = u.pn * BM + wc * 32 + 8 * fq;
#pragma unroll
        for (int ai = 0; ai < 2; ++ai)
#pragma unroll
            for (int m = 0; m < 4; ++m) { bf16_t* rowp = O + (size_t)(row0 + ai * HALF + m * 16) * ldc + col0;
#pragma unroll
                for (int bj = 0; bj < 2; ++bj) { const f32x4 v0 = acc[ai][bj][m][0], v1 = acc[ai][bj][m][1];
                    u32x4 w; w.x = cvt_pk_bf16(v0[0], v0[1]); w.y = cvt_pk_bf16(v0[2], v0[3]); w.z = cvt_pk_bf16(v1[0], v1[1]); w.w = cvt_pk_bf16(v1[2], v1[3]);
                    *(u32x4*)(rowp + bj * HALF) = w; } }
    }
};
struct EpiProj {
    static constexpr bool PERM = true, AFTER_DRAIN = false;
    bf16_t* O; int ldc; const float* bias; int rope_lo, rope_hi; const float* rope;
    __device__ __forceinline__ void operator()(const f32x4 (&acc)[2][2][4][2], const Unit& u, int wr, int wc, int fr, int fq) const {
        const int row0 = u.pm * BM + wr * 64 + fr, col0 = u.pn * BM + wc * 32 + 8 * fq;
        const bool rp = (u.pn >= rope_lo) && (u.pn < rope_hi);
        f32x4 bv[2][2];
#pragma unroll
        for (int bj = 0; bj < 2; ++bj)
#pragma unroll
            for (int n = 0; n < 2; ++n) bv[bj][n] = *(const f32x4*)(bias + col0 + bj * HALF + 4 * n);
        const int f0 = wc * 16 + 4 * fq;
#pragma unroll
        for (int ai = 0; ai < 2; ++ai)
#pragma unroll
            for (int m = 0; m < 4; ++m) { const int row = row0 + ai * HALF + m * 16; bf16_t* rowp = O + (size_t)row * ldc + col0;
                f32x4 cs0 = (f32x4){1.f, 0.f, 1.f, 0.f}, cs1 = cs0;
                if (rp) { const float* rt = rope + ((size_t)(row & (4096 - 1)) * 64 + f0) * 2; cs0 = *(const f32x4*)rt; cs1 = *(const f32x4*)(rt + 4); }
#pragma unroll
                for (int bj = 0; bj < 2; ++bj) { f32x4 v0 = acc[ai][bj][m][0] + bv[bj][0], v1 = acc[ai][bj][m][1] + bv[bj][1];
                    if (rp) { const f32x4 a = v0, b = v1;
                        v0[0] = a[0] * cs0[0] - a[1] * cs0[1]; v0[1] = a[1] * cs0[0] + a[0] * cs0[1];
                        v0[2] = a[2] * cs0[2] - a[3] * cs0[3]; v0[3] = a[3] * cs0[2] + a[2] * cs0[3];
                        v1[0] = b[0] * cs1[0] - b[1] * cs1[1]; v1[1] = b[1] * cs1[0] + b[0] * cs1[1];
                        v1[2] = b[2] * cs1[2] - b[3] * cs1[3]; v1[3] = b[3] * cs1[2] + b[2] * cs1[3]; }
                    u32x4 w; w.x = cvt_pk_bf16(v0[0], v0[1]); w.y = cvt_pk_bf16(v0[2], v0[3]); w.z = cvt_pk_bf16(v1[0], v1[1]); w.w = cvt_pk_bf16(v1[2], v1[3]);
                    *(u32x4*)(rowp + bj * HALF) = w; } }
    }
};
struct EpiResid {
    static constexpr bool PERM = false, AFTER_DRAIN = false;
    float* X; int ldc; float alpha;
    __device__ __forceinline__ void operator()(const f32x4 (&acc)[2][2][4][2], const Unit& u, int wr, int wc, int fr, int fq) const {
        const int row0 = u.pm * BM + wr * 64 + fr, col0 = u.pn * BM + wc * 32 + 4 * fq;
#pragma unroll
        for (int ai = 0; ai < 2; ++ai)
#pragma unroll
            for (int m = 0; m < 4; ++m) { float* rowp = X + (size_t)(row0 + ai * HALF + m * 16) * ldc + col0;
                f32x4 xv[2][2];
#pragma unroll
                for (int bj = 0; bj < 2; ++bj)
#pragma unroll
                    for (int n = 0; n < 2; ++n) xv[bj][n] = *(const f32x4*)(rowp + bj * HALF + n * 16);
#pragma unroll
                for (int bj = 0; bj < 2; ++bj)
#pragma unroll
                    for (int n = 0; n < 2; ++n) *(f32x4*)(rowp + bj * HALF + n * 16) = xv[bj][n] * alpha + acc[ai][bj][m][n];
                asm volatile("" ::: "memory"); }
    }
};

template <class Epi, class Sched, bool ALIGN_EPI = false, bool SP2 = false>
__device__ __forceinline__ void gemm_phase(PG8_LAS unsigned char* lds, const Gemm g, const Sched& S, const Epi& E) {
    int tid_l = threadIdx.x; asm volatile("" : "+v"(tid_l));
    const int tid = tid_l, wid = __builtin_amdgcn_readfirstlane(tid >> 6), lane = tid & 63, wr = wid >> 2, wc = wid & 3, fr = lane & 15, fq = lane >> 4;
    const int K = g.K, nt = K / BK;
    unsigned voffA[2], voffB[2];
#pragma unroll
    for (int i = 0; i < 2; ++i) { int R, C; stage_rc(tid * 16 + i * 8192, R, C); const int Rb = Epi::PERM ? ((R & ~31) + perm32(R & 31)) : R;
        voffA[i] = (unsigned)(R * K + C) * 2u; voffB[i] = (unsigned)(Rb * K + C) * 2u; }
    const size_t kstep = (size_t)(BK * 2);
    const size_t hstep = (size_t)HALF * K * 2;
    const size_t tstep = 2 * hstep;
    const unsigned ldsw = (unsigned)wid * 1024u;
    const int aoff = lds_byte(wr * 64 + fr, fq * 8), boff = lds_byte(wc * 32 + fr, fq * 8);
#define PG8_SA(b, h) (((b) * 2 + (h)) * HTB)
#define PG8_SB(b, h) ((4 + (b) * 2 + (h)) * HTB)
#define PG8_STAGE(bufoff, gbase, voff) do { _Pragma("unroll") for (int _i = 0; _i < 2; ++_i) \
        __builtin_amdgcn_global_load_lds((const unsigned*)((const char*)(gbase) + (voff)[_i]), (PG8_LAS unsigned*)(lds + (bufoff) + ldsw + _i * 8192), 16, 0, 0); } while (0)
#define PG8_LDA(dst, b, h) do { _Pragma("unroll") for (int m = 0; m < 4; ++m) _Pragma("unroll") for (int k = 0; k < 2; ++k) dst[m][k] = *(const PG8_LAS bf16x8*)(lds + PG8_SA(b, h) + aoff + m * 2048 + k * 1024); } while (0)
#define PG8_LDB(dst, b, h) do { _Pragma("unroll") for (int n = 0; n < 2; ++n) _Pragma("unroll") for (int k = 0; k < 2; ++k) dst[n][k] = *(const PG8_LAS bf16x8*)(lds + PG8_SB(b, h) + boff + n * 2048 + k * 1024); } while (0)
#define PG8_MMA(ai, bj, At, Bt) do { __builtin_amdgcn_s_setprio(1); _Pragma("unroll") for (int m = 0; m < 4; ++m) _Pragma("unroll") for (int n = 0; n < 2; ++n) _Pragma("unroll") for (int k = 0; k < 2; ++k) \
        acc[ai][bj][m][n] = __builtin_amdgcn_mfma_f32_16x16x32_bf16(Bt[n][k], At[m][k], acc[ai][bj][m][n], 0, 0, 0); __builtin_amdgcn_s_setprio(0); } while (0)
#define PG8_WAIT_V(n) asm volatile("s_waitcnt vmcnt(" #n ")" ::: "memory")
#define PG8_WAIT_L(n) asm volatile("s_waitcnt lgkmcnt(" #n ")" ::: "memory")
#define PG8_BAR __builtin_amdgcn_s_barrier()
#define PG8_SCHED __builtin_amdgcn_sched_barrier(0)
    Unit cur, nxt; int ui = 0;
    if (!S.next(0, cur)) return;
    f32x4 acc[2][2][4][2];
#pragma unroll
    for (int a = 0; a < 2; ++a)
#pragma unroll
        for (int b = 0; b < 2; ++b)
#pragma unroll
            for (int m = 0; m < 4; ++m)
#pragma unroll
                for (int n = 0; n < 2; ++n) acc[a][b][m][n] = (f32x4){0.f, 0.f, 0.f, 0.f};
    bf16x8 At[4][2], B0[2][2], B1[2][2];
    const char* cA = (const char*)g.A + (size_t)cur.pm * tstep; const char* cB = (const char*)g.Bt + (size_t)cur.pn * tstep;
    S.a_ready(cur);
    if constexpr (SP2) {
        PG8_STAGE(PG8_SB(0, 0), cB, voffB); PG8_STAGE(PG8_SB(0, 1), cB + hstep, voffB); PG8_STAGE(PG8_SA(0, 0), cA, voffA); PG8_STAGE(PG8_SA(0, 1), cA + hstep, voffA);
        if (wr == 1) PG8_BAR;
        PG8_WAIT_V(2); PG8_BAR;
        PG8_STAGE(PG8_SB(1, 0), cB + kstep, voffB); PG8_STAGE(PG8_SA(1, 0), cA + kstep, voffA); PG8_STAGE(PG8_SB(1, 1), cB + hstep + kstep, voffB);
        PG8_WAIT_V(6); PG8_BAR;
    } else {
        PG8_STAGE(PG8_SB(0, 0), cB, voffB); PG8_STAGE(PG8_SA(0, 0), cA, voffA); PG8_STAGE(PG8_SB(0, 1), cB + hstep, voffB); PG8_STAGE(PG8_SA(0, 1), cA + hstep, voffA);
        if (wr == 1) PG8_BAR;
        PG8_WAIT_V(4); PG8_BAR;
        PG8_STAGE(PG8_SB(1, 0), cB + kstep, voffB); PG8_STAGE(PG8_SA(1, 0), cA + kstep, voffA); PG8_STAGE(PG8_SB(1, 1), cB + hstep + kstep, voffB);
        PG8_WAIT_V(6); PG8_BAR;
    }
    for (;;) {
        const bool has_next = S.next(ui + 1, nxt);
        const char* nA = has_next ? (const char*)g.A + (size_t)nxt.pm * tstep : cA; const char* nB = has_next ? (const char*)g.Bt + (size_t)nxt.pn * tstep : cB;
        for (int t = 0; t < nt; t += 2) {
            const bool last = (t == nt - 2);
            const char* a1 = cA + (size_t)(t + 1) * kstep;
            const char* a2 = last ? nA : cA + (size_t)(t + 2) * kstep; const char* b2 = last ? nB : cB + (size_t)(t + 2) * kstep;
            const char* a3 = a2 + kstep; const char* b3 = b2 + kstep;
            if (last && has_next) S.a_ready(nxt);
            if constexpr (SP2) {
            PG8_LDB(B0, 0, 0); PG8_LDB(B1, 0, 1); PG8_SCHED; PG8_LDA(At, 0, 0); PG8_STAGE(PG8_SA(1, 1), a1 + hstep, voffA);
            PG8_WAIT_V(8); PG8_WAIT_L(0); PG8_BAR; PG8_MMA(0, 0, At, B0); PG8_MMA(0, 1, At, B1); PG8_BAR; PG8_SCHED;
            PG8_LDA(At, 0, 1); PG8_STAGE(PG8_SB(0, 0), b2, voffB); PG8_STAGE(PG8_SB(0, 1), b2 + hstep, voffB); PG8_STAGE(PG8_SA(0, 0), a2, voffA);
            PG8_WAIT_V(8); PG8_WAIT_L(0); PG8_BAR; PG8_MMA(1, 0, At, B0); PG8_MMA(1, 1, At, B1); PG8_BAR; PG8_SCHED;
            PG8_LDB(B0, 1, 0); PG8_LDB(B1, 1, 1); PG8_SCHED; PG8_LDA(At, 1, 0); PG8_STAGE(PG8_SA(0, 1), a2 + hstep, voffA);
            PG8_WAIT_V(8); PG8_WAIT_L(0); PG8_BAR; PG8_MMA(0, 0, At, B0); PG8_MMA(0, 1, At, B1); PG8_BAR; PG8_SCHED;
            PG8_LDA(At, 1, 1); PG8_STAGE(PG8_SB(1, 0), b3, voffB); PG8_STAGE(PG8_SB(1, 1), b3 + hstep, voffB); PG8_STAGE(PG8_SA(1, 0), a3, voffA);
            PG8_WAIT_V(8); PG8_WAIT_L(0); PG8_BAR; PG8_MMA(1, 0, At, B0); PG8_MMA(1, 1, At, B1); PG8_BAR; PG8_SCHED;
            } else {
            PG8_LDB(B0, 0, 0); PG8_SCHED; PG8_LDA(At, 0, 0); PG8_STAGE(PG8_SA(1, 1), a1 + hstep, voffA);
            PG8_WAIT_L(8); PG8_BAR; PG8_WAIT_L(0); PG8_MMA(0, 0, At, B0); PG8_BAR; PG8_SCHED;
            PG8_LDB(B1, 0, 1); PG8_STAGE(PG8_SB(0, 0), b2, voffB);
            PG8_BAR; PG8_WAIT_L(0); PG8_MMA(0, 1, At, B1); PG8_BAR;
            PG8_LDA(At, 0, 1); PG8_STAGE(PG8_SA(0, 0), a2, voffA);
            PG8_BAR; PG8_WAIT_L(0); PG8_MMA(1, 0, At, B0); PG8_BAR; PG8_SCHED;
            PG8_STAGE(PG8_SB(0, 1), b2 + hstep, voffB);
            PG8_WAIT_V(6); PG8_BAR; PG8_MMA(1, 1, At, B1); PG8_BAR;
            PG8_LDB(B0, 1, 0); PG8_SCHED; PG8_LDA(At, 1, 0); PG8_STAGE(PG8_SA(0, 1), a2 + hstep, voffA);
            PG8_WAIT_L(8); PG8_BAR; PG8_WAIT_L(0); PG8_MMA(0, 0, At, B0); PG8_BAR; PG8_SCHED;
            PG8_LDB(B1, 1, 1); PG8_STAGE(PG8_SB(1, 0), b3, voffB);
            PG8_BAR; PG8_WAIT_L(0); PG8_MMA(0, 1, At, B1); PG8_BAR;
            PG8_LDA(At, 1, 1); PG8_STAGE(PG8_SA(1, 0), a3, voffA);
            PG8_BAR; PG8_WAIT_L(0); PG8_MMA(1, 0, At, B0); PG8_BAR; PG8_SCHED;
            PG8_STAGE(PG8_SB(1, 1), b3 + hstep, voffB);
            PG8_WAIT_V(6); PG8_BAR; PG8_MMA(1, 1, At, B1); PG8_BAR;
            }
        }
        if constexpr (ALIGN_EPI) { if (wr == 0) PG8_BAR; }
        if constexpr (!Epi::AFTER_DRAIN) { E(acc, cur, wr, wc, fr, fq); S.done(cur); }
        if (!has_next) break;
#pragma unroll
        for (int a = 0; a < 2; ++a)
#pragma unroll
            for (int b = 0; b < 2; ++b)
#pragma unroll
                for (int m = 0; m < 4; ++m)
#pragma unroll
                    for (int n = 0; n < 2; ++n) acc[a][b][m][n] = (f32x4){0.f, 0.f, 0.f, 0.f};
        cur = nxt; cA = nA; cB = nB; ++ui;
        if constexpr (ALIGN_EPI) { if (wr == 1) PG8_BAR; }
    }
    PG8_WAIT_V(0);
    if constexpr (!ALIGN_EPI) { if (wr == 0) PG8_BAR; }
    PG8_BAR;
    if constexpr (Epi::AFTER_DRAIN) { E.fused(acc, cur, wr, wc, fr, fq, lds, wid, lane); S.done(cur); }
#undef PG8_SA
#undef PG8_SB
#undef PG8_STAGE
#undef PG8_LDA
#undef PG8_LDB
#undef PG8_MMA
#undef PG8_WAIT_V
#undef PG8_WAIT_L
#undef PG8_BAR
#undef PG8_SCHED
}
}

#define GAS __attribute__((address_space(1)))
#define LAS __attribute__((address_space(3)))
typedef unsigned short bf16;
typedef unsigned v4u __attribute__((ext_vector_type(4)));
typedef unsigned v2u __attribute__((ext_vector_type(2)));
typedef float f32x4 __attribute__((ext_vector_type(4)));
typedef float f32x16 __attribute__((ext_vector_type(16)));
typedef short bf16x8 __attribute__((ext_vector_type(8)));
typedef short s16x4 __attribute__((ext_vector_type(4)));
typedef GAS unsigned gu32;
#define RLX_AGENT __ATOMIC_RELAXED, __HIP_MEMORY_SCOPE_AGENT
#define LDS_WAIT() asm volatile("s_waitcnt lgkmcnt(0)" ::: "memory")
#define VM_WAIT() asm volatile("s_waitcnt vmcnt(0)" ::: "memory")
__device__ __forceinline__ unsigned f2bf(float f) { unsigned u = __builtin_bit_cast(unsigned, f); return (u + 0x7fffu + ((u >> 16) & 1u)) >> 16; }
__device__ __forceinline__ unsigned pk2(float lo, float hi) { return f2bf(lo) | (f2bf(hi) << 16); }
__device__ __forceinline__ float bf2f(unsigned short b) { return __builtin_bit_cast(float, (unsigned)b << 16); }
__device__ __forceinline__ float bflo(unsigned w) { return __builtin_bit_cast(float, w << 16); }
__device__ __forceinline__ float bfhi(unsigned w) { return __builtin_bit_cast(float, w & 0xffff0000u); }
__device__ __forceinline__ float wave_sum(float v) {
#pragma unroll
    for (int o = 1; o < 64; o <<= 1) v += __shfl_xor(v, o);
    return v;
}
__device__ __forceinline__ float wave_max(float v) {
#pragma unroll
    for (int o = 1; o < 64; o <<= 1) v = fmaxf(v, __shfl_xor(v, o));
    return v;
}
__device__ __forceinline__ float log_sigmoid(float x) { return fminf(x, 0.f) - log1pf(expf(-fabsf(x))); }

#define XB_TMO      128
#define XB_XCNT(j)  (256  + 64 * (j))
#define XB_XSUB(j)  (1280 + 64 * (j))
#define XB_XGEN(j)  (2304 + 64 * (j))
#define XB_TOP      3328
#define XB_TOPGEN   3392
#define XCD_BAR_WORDS 3456
#define XB_SPIN_CAP (1u << 18)

__device__ __forceinline__ unsigned xb_ld(unsigned* p)              { return __hip_atomic_load(p, __ATOMIC_RELAXED, __HIP_MEMORY_SCOPE_AGENT); }
__device__ __forceinline__ unsigned xb_add(unsigned* p, unsigned v) { return __hip_atomic_fetch_add(p, v, __ATOMIC_RELAXED, __HIP_MEMORY_SCOPE_AGENT); }
__device__ __forceinline__ unsigned xb_xcc_id() { return (unsigned)__builtin_amdgcn_s_getreg((3 << 11) | 20) & 0xFu; }
#define XB_SPIN(cond, bar) do { unsigned _sp = 0; while (cond) { __builtin_amdgcn_s_sleep(1); \
    if ((++_sp & 255u) == 0u) { if (xb_ld(&(bar)[XB_TMO])) break; if (_sp > XB_SPIN_CAP) { atomicAdd(&(bar)[XB_TMO], 1u); break; } } } } while (0)

struct XcdBarrier {
    unsigned* bar; unsigned x;
    volatile LAS unsigned* st;
};

__device__ __forceinline__ XcdBarrier xcd_barrier_post(unsigned* bar, volatile LAS unsigned* st) {
    XcdBarrier b; b.bar = bar; b.x = xb_xcc_id(); b.st = st;
    if (threadIdx.x == 0) (void)xb_add(&bar[XB_XCNT(b.x)], 1u);
    return b;
}
__device__ __forceinline__ void xcd_barrier_complete(unsigned* bar, unsigned x, unsigned& nloc, unsigned& nx) {
    const unsigned G = gridDim.x * gridDim.y * gridDim.z;
    unsigned sum, cnt, mine, sp = 0u;
    for (;;) {
        sum = 0u; cnt = 0u; mine = 0u;
#pragma unroll
        for (unsigned j = 0; j < 16; ++j) { const unsigned c = xb_ld(&bar[XB_XCNT(j)]); sum += c; cnt += (c > 0u) ? 1u : 0u; mine = (j == x) ? c : mine; }
        if (sum == G) break;
        __builtin_amdgcn_s_sleep(1);
        if ((++sp & 255u) == 0u) { if (xb_ld(&bar[XB_TMO])) break; if (sp > XB_SPIN_CAP) { atomicAdd(&bar[XB_TMO], 1u); break; } }
    }
    nloc = mine > 0u ? mine : 1u; nx = cnt > 0u ? cnt : 1u;
}

__device__ __forceinline__ void xcd_barrier(const XcdBarrier& b) {
    asm volatile("s_waitcnt vmcnt(0)" ::: "memory");
    __syncthreads();
    if (threadIdx.x == 0) {
        unsigned* bar = b.bar;
        __builtin_amdgcn_s_waitcnt(0);
        unsigned nloc = b.st[0], nx = b.st[1];
        if (nloc == 0u) { xcd_barrier_complete(bar, b.x, nloc, nx); b.st[0] = nloc; b.st[1] = nx; }
        const unsigned old = xb_add(&bar[XB_XSUB(b.x)], 1u);
        const unsigned gen = old / nloc;
        if (old + 1u == (gen + 1u) * nloc) {
            __builtin_amdgcn_fence(__ATOMIC_RELEASE, "agent");
            asm volatile("s_waitcnt vmcnt(0)" ::: "memory");
            const unsigned og = xb_add(&bar[XB_TOP], 1u);
            const unsigned tg = og / nx;
            if (og + 1u == (tg + 1u) * nx) xb_add(&bar[XB_TOPGEN], 1u);
            else XB_SPIN(xb_ld(&bar[XB_TOPGEN]) == tg, bar);
            __builtin_amdgcn_fence(__ATOMIC_ACQUIRE, "agent");
            xb_add(&bar[XB_XGEN(b.x)], 1u);
            asm volatile("s_waitcnt vmcnt(0)" ::: "memory");
        } else {
            XB_SPIN(xb_ld(&bar[XB_XGEN(b.x)]) == gen, bar);
            __builtin_amdgcn_fence(__ATOMIC_ACQUIRE, "agent");
            asm volatile("s_waitcnt vmcnt(0)" ::: "memory");
        }
    }
    __syncthreads();
}

constexpr size_t MiB = 1u << 20;
constexpr size_t WS_CTL = 0, CTL_ZERO_BYTES = 1 * MiB;
constexpr size_t WS_ROPE = 1 * MiB;
constexpr size_t WS_BIASA = 3 * MiB;
constexpr size_t WS_CONVW = 3 * MiB + 65536;
constexpr size_t WS_CONVB = WS_CONVW + (size_t)4 * 3 * UPN * 4;
constexpr size_t WS_GATES = 4 * MiB;
constexpr size_t WS_WG = 5 * MiB;
constexpr size_t WS_WAIN = 6 * MiB, WS_WAOUT = 42 * MiB, WS_WMIN = 58 * MiB, WS_WMOUT = 106 * MiB, WS_WUP = 122 * MiB, WS_WDN = 298 * MiB;
constexpr size_t WS_X = 386 * MiB;
constexpr size_t WS_XB = 514 * MiB;
constexpr size_t WS_R1 = 578 * MiB;
constexpr size_t WS_PROJ = WS_R1, WS_HEADS = WS_R1 + 192 * MiB;
constexpr size_t WS_H = 930 * MiB;
constexpr size_t WS_END = 1106 * MiB;
constexpr size_t WS_FOXC = 1106 * MiB;
constexpr size_t WS_NEED = 1108 * MiB;
static_assert(WS_CONVB + (size_t)4 * UPN * 4 <= WS_GATES && WS_WAIN + (size_t)2 * ATT_N * DM * 2 <= WS_WAOUT && WS_WMIN + (size_t)2 * ML_N * DM * 2 <= WS_WMOUT &&
              WS_WUP + (size_t)4 * UPN * DM * 2 <= WS_WDN && WS_WDN + (size_t)4 * DM * DFF * 2 <= WS_X && WS_R1 + (size_t)MTOK * UPN * 2 <= WS_H && WS_H + (size_t)MTOK * DFF * 2 <= WS_END, "ws map");
constexpr int CW_BAR = 4096;
constexpr int BAR_STRIDE = 4096;

constexpr int RING_BYTES = 131072;
constexpr int LDSCTL_OFF = RING_BYTES;
constexpr int LDS_BYTES = 147456;
constexpr int NWAVES = 8, NTHREADS = 512;

enum { MAP_ID = 0, MAP_ATT = 1, MAP_ATTG = 2, MAP_MLG = 3, MAP_UP = 4 };
__device__ __forceinline__ int src_col(int kind, int n) {
    if (kind == MAP_ATT) {
        if (n < 3072) return n;
        if (n < 4352) { const int base = n < 4096 ? 3072 : 4096, sbase = n < 4096 ? 3080 : 4104, r = n - base, hh = r >> 7, p = r & 127; return sbase + hh * 128 + (p >> 1) + ((p & 1) << 6); }
        return 4360 + (n - 4352);
    }
    if (kind == MAP_ATTG) return n < 8 ? 3072 + n : -1;
    if (kind == MAP_MLG) return n < 16 ? 6144 + n : -1;
    if (kind == MAP_UP) { const int tile = n >> 8, w = n & 255; return w < 128 ? tile * 128 + w : DFF + tile * 128 + (w - 128); }
    return n;
}
__device__ __forceinline__ void tr_item(const float* W, int K, int Nsrc, int Nd, bf16* WT, int kind, LAS float* scr, int item, int lane) {
    const int nblk = Nd / 32, kb = item / nblk, nb = item % nblk, k0 = 64 * kb, n0 = 32 * nb;
    const int c = src_col(kind, n0 + (lane & 31));
#pragma unroll 8
    for (int i = 0; i < 32; ++i) { const int kk = 2 * i + (lane >> 5); scr[kk * 33 + (lane & 31)] = c >= 0 ? W[(size_t)(k0 + kk) * Nsrc + c] : 0.f; }
    LDS_WAIT(); asm volatile("" ::: "memory");
    const int ch = lane & 7;
#pragma unroll
    for (int j = 0; j < 4; ++j) { const int n = (lane >> 3) + 8 * j; const LAS float* s = scr + (8 * ch) * 33 + n;
        v4u o; o.x = pk2(s[0 * 33], s[1 * 33]); o.y = pk2(s[2 * 33], s[3 * 33]); o.z = pk2(s[4 * 33], s[5 * 33]); o.w = pk2(s[6 * 33], s[7 * 33]);
        *(GAS v4u*)(WT + (size_t)(n0 + n) * K + k0 + 8 * ch) = o; }
    LDS_WAIT(); asm volatile("" ::: "memory");
}

struct Args { const float* in[16]; float* out; unsigned char* ws; int ph_lo, ph_hi, bar_region, pad; };

__device__ __forceinline__ void p0_prologue(const Args& a, LAS unsigned char* lds, int vcu, int G, int wave, int lane, int tid) {
    unsigned char* ws = a.ws;
    LAS float* scr = (LAS float*)(lds + wave * 16384);
    const int gw = vcu * NWAVES + wave, NGW = G * NWAVES;
    constexpr int KB = DM / 64;
    constexpr int I_AIN = KB * (ATT_N / 32), I_G = KB * 1, I_OUT = KB * (DM / 32), I_MIN = KB * (ML_N / 32), I_UP = KB * (UPN / 32), I_DN = (DFF / 64) * (DM / 32);
    constexpr int NITEMS = 2 * (I_AIN + I_G + I_OUT + I_MIN + I_G + I_OUT) + 4 * (I_UP + I_DN);
    for (int it = gw; it < NITEMS; it += NGW) {
        int r = it;
        if (r < 4 * I_UP) { const int l = r / I_UP; tr_item(a.in[8] + (size_t)l * DM * UPN, DM, UPN, UPN, (bf16*)(ws + WS_WUP) + (size_t)l * UPN * DM, MAP_UP, scr, r % I_UP, lane); continue; } r -= 4 * I_UP;
        if (r < 4 * I_DN) { const int l = r / I_DN; tr_item(a.in[11] + (size_t)l * DFF * DM, DFF, DM, DM, (bf16*)(ws + WS_WDN) + (size_t)l * DM * DFF, MAP_ID, scr, r % I_DN, lane); continue; } r -= 4 * I_DN;
        if (r < 2 * I_AIN) { const int l = r / I_AIN; tr_item(a.in[1] + (size_t)l * DM * ATT_IN, DM, ATT_IN, ATT_N, (bf16*)(ws + WS_WAIN) + (size_t)l * ATT_N * DM, MAP_ATT, scr, r % I_AIN, lane); continue; } r -= 2 * I_AIN;
        if (r < 2 * I_MIN) { const int l = r / I_MIN; tr_item(a.in[5] + (size_t)l * DM * ML_IN, DM, ML_IN, ML_N, (bf16*)(ws + WS_WMIN) + (size_t)l * ML_N * DM, MAP_ID, scr, r % I_MIN, lane); continue; } r -= 2 * I_MIN;
        if (r < 2 * I_OUT) { const int l = r / I_OUT; tr_item(a.in[4] + (size_t)l * DM * DM, DM, DM, DM, (bf16*)(ws + WS_WAOUT) + (size_t)l * DM * DM, MAP_ID, scr, r % I_OUT, lane); continue; } r -= 2 * I_OUT;
        if (r < 2 * I_OUT) { const int l = r / I_OUT; tr_item(a.in[7] + (size_t)l * DM * DM, DM, DM, DM, (bf16*)(ws + WS_WMOUT) + (size_t)l * DM * DM, MAP_ID, scr, r % I_OUT, lane); continue; } r -= 2 * I_OUT;
        if (r < 2 * I_G) { const int l = r / I_G; tr_item(a.in[1] + (size_t)l * DM * ATT_IN, DM, ATT_IN, 32, (bf16*)(ws + WS_WG) + (size_t)l * 32 * DM, MAP_ATTG, scr, r % I_G, lane); continue; } r -= 2 * I_G;
        { const int l = r / I_G; tr_item(a.in[5] + (size_t)l * DM * ML_IN, DM, ML_IN, 32, (bf16*)(ws + WS_WG) + (size_t)(2 + l) * 32 * DM, MAP_MLG, scr, r % I_G, lane); }
    }
    { const float* x = a.in[0]; float* X = (float*)(ws + WS_X); bf16* XB = (bf16*)(ws + WS_XB);
      for (int m = gw; m < MTOK; m += NGW) {
          const GAS f32x4* xr = (const GAS f32x4*)(x + (size_t)m * DM) + lane; GAS f32x4* o = (GAS f32x4*)(X + (size_t)m * DM) + lane; GAS v2u* ob = (GAS v2u*)(XB + (size_t)m * DM) + lane;
#pragma unroll
          for (int j = 0; j < 8; ++j) { const f32x4 v = xr[64 * j]; o[64 * j] = v; v2u w; w.x = pk2(v.x, v.y); w.y = pk2(v.z, v.w); ob[64 * j] = w; } } }
    const int gt = (vcu * NTHREADS) + tid, NGT = G * NTHREADS;
    { float* rope = (float*)(ws + WS_ROPE);
      for (int i = gt; i < 4096 * 64; i += NGT) { const int pos = i >> 6, f = i & 63;
          const float inv = powf(10000.0f, -(float)f * (2.0f / 128.0f)); const float ang = (float)pos * inv;
          double ad = (double)ang; ad -= 6.283185307179586476925 * rint(ad * 0.15915494309189533577);
          const float ar = (float)ad; rope[2 * i] = cosf(ar); rope[2 * i + 1] = sinf(ar); } }
    { float* bA = (float*)(ws + WS_BIASA);
      for (int i = gt; i < 2 * ATT_N; i += NGT) { const int l = i / ATT_N, n = i % ATT_N; bA[i] = a.in[2][(size_t)l * ATT_IN + src_col(MAP_ATT, n)]; } }
    { float* cw = (float*)(ws + WS_CONVW); float* cb = (float*)(ws + WS_CONVB);
      for (int i = gt; i < 4 * 3 * UPN; i += NGT) { const int lj = i / UPN, n = i % UPN; cw[i] = a.in[9][(size_t)lj * UPN + src_col(MAP_UP, n)]; }
      for (int i = gt; i < 4 * UPN; i += NGT) { const int l = i / UPN, n = i % UPN; cb[i] = a.in[10][(size_t)l * UPN + src_col(MAP_UP, n)]; } }
}

__device__ __forceinline__ void gates_phase(const bf16* XB, const bf16* WG, const float* bsrc, int nb, float* GATES, int gw, int NGW, int lane) {
    typedef float f4 __attribute__((ext_vector_type(4)));
    for (int task = gw; task < MTOK / 16; task += NGW) {
        const int m0 = task * 16;
        f4 acc = (f4){0.f, 0.f, 0.f, 0.f};
        const bf16* ap = XB + (size_t)(m0 + (lane & 15)) * DM + 8 * (lane >> 4);
        const bf16* bp = WG + (size_t)(lane & 15) * DM + 8 * (lane >> 4);
#pragma unroll 8
        for (int k0 = 0; k0 < DM; k0 += 32) { const bf16x8 av = *(const bf16x8*)(ap + k0); const bf16x8 bv = *(const bf16x8*)(bp + k0); acc = __builtin_amdgcn_mfma_f32_16x16x32_bf16(av, bv, acc, 0, 0, 0); }
        const int g = lane & 15; const float bias = g < nb ? bsrc[g] : 0.f;
#pragma unroll
        for (int r = 0; r < 4; ++r) GATES[(size_t)(m0 + (lane >> 4) * 4 + r) * 16 + g] = acc[r] + bias;
    }
}

__device__ __forceinline__ void ln_phase(const float* X, float* Xo, bf16* XBo, const float* g, const float* b, int gw, int NGW, int lane) {
    f32x4 gv[8], bv[8];
#pragma unroll
    for (int j = 0; j < 8; ++j) { gv[j] = ((const f32x4*)g)[lane + 64 * j]; bv[j] = ((const f32x4*)b)[lane + 64 * j]; }
    for (int m = gw; m < MTOK; m += NGW) {
        const GAS f32x4* xr = (const GAS f32x4*)(X + (size_t)m * DM) + lane;
        f32x4 v[8]; float s = 0.f;
#pragma unroll
        for (int j = 0; j < 8; ++j) { v[j] = xr[64 * j]; s += (v[j].x + v[j].y) + (v[j].z + v[j].w); }
        const float mean = wave_sum(s) * (1.f / DM); float s2 = 0.f;
#pragma unroll
        for (int j = 0; j < 8; ++j) { v[j] = v[j] - mean; s2 += (v[j].x * v[j].x + v[j].y * v[j].y) + (v[j].z * v[j].z + v[j].w * v[j].w); }
        const float rstd = 1.f / sqrtf(wave_sum(s2) * (1.f / DM) + LN_EPS);
        GAS f32x4* o = (GAS f32x4*)(Xo + (size_t)m * DM) + lane;
#pragma unroll
        for (int j = 0; j < 8; ++j) { v[j] = v[j] * rstd * gv[j] + bv[j]; o[64 * j] = v[j]; }
        if (XBo) { GAS v2u* ob = (GAS v2u*)(XBo + (size_t)m * DM) + lane;
#pragma unroll
            for (int j = 0; j < 8; ++j) { v2u w; w.x = pk2(v[j].x, v[j].y); w.y = pk2(v[j].z, v[j].w); ob[64 * j] = w; } }
    }
}

__device__ __forceinline__ void conv_phase(const bf16* U, bf16* H, const float* cw  , const float* cb  , int gt, int NGT) {
    constexpr int RS = 16, NSTRIP = MTOK / RS, NCG = (UPN / 256) * 16;
    for (int it = gt; it < NSTRIP * NCG; it += NGT) {
        const int strip = it / NCG, cg = it % NCG, tile = cg >> 4, g8 = cg & 15;
        const int pc = tile * 256 + g8 * 8;
        const int t0 = strip * RS;
        float wg[3][8], wv[3][8], bg[8], bvv[8];
#pragma unroll
        for (int j = 0; j < 3; ++j) { const f32x4 a0 = *(const f32x4*)(cw + (size_t)j * UPN + pc), a1 = *(const f32x4*)(cw + (size_t)j * UPN + pc + 4), c0 = *(const f32x4*)(cw + (size_t)j * UPN + pc + 128), c1 = *(const f32x4*)(cw + (size_t)j * UPN + pc + 132);
#pragma unroll
            for (int e = 0; e < 4; ++e) { wg[j][e] = a0[e]; wg[j][4 + e] = a1[e]; wv[j][e] = c0[e]; wv[j][4 + e] = c1[e]; } }
        { const f32x4 a0 = *(const f32x4*)(cb + pc), a1 = *(const f32x4*)(cb + pc + 4), c0 = *(const f32x4*)(cb + pc + 128), c1 = *(const f32x4*)(cb + pc + 132);
#pragma unroll
          for (int e = 0; e < 4; ++e) { bg[e] = a0[e]; bg[4 + e] = a1[e]; bvv[e] = c0[e]; bvv[4 + e] = c1[e]; } }
        float g2[8], g1[8], v2[8], v1[8];
        const bool first = (t0 & (SEQ - 1)) == 0;
#pragma unroll
        for (int e = 0; e < 8; ++e) { g2[e] = 0.f; g1[e] = 0.f; v2[e] = 0.f; v1[e] = 0.f; }
        if (!first) {
            const v4u a = *(const v4u*)(U + (size_t)(t0 - 2) * UPN + pc), b = *(const v4u*)(U + (size_t)(t0 - 1) * UPN + pc), c = *(const v4u*)(U + (size_t)(t0 - 2) * UPN + pc + 128), d = *(const v4u*)(U + (size_t)(t0 - 1) * UPN + pc + 128);
#pragma unroll
            for (int e = 0; e < 4; ++e) { g2[2 * e] = bflo(a[e]); g2[2 * e + 1] = bfhi(a[e]); g1[2 * e] = bflo(b[e]); g1[2 * e + 1] = bfhi(b[e]);
                                          v2[2 * e] = bflo(c[e]); v2[2 * e + 1] = bfhi(c[e]); v1[2 * e] = bflo(d[e]); v1[2 * e + 1] = bfhi(d[e]); }
        }
#pragma unroll 4
        for (int r = 0; r < RS; ++r) {
            const int t = t0 + r;
            const v4u a = *(const v4u*)(U + (size_t)t * UPN + pc), c = *(const v4u*)(U + (size_t)t * UPN + pc + 128);
            float g0[8], v0[8], o[8];
#pragma unroll
            for (int e = 0; e < 4; ++e) { g0[2 * e] = bflo(a[e]); g0[2 * e + 1] = bfhi(a[e]); v0[2 * e] = bflo(c[e]); v0[2 * e + 1] = bfhi(c[e]); }
#pragma unroll
            for (int e = 0; e < 8; ++e) {
                const float cgt = bg[e] + wg[0][e] * g2[e] + wg[1][e] * g1[e] + wg[2][e] * g0[e];
                const float cvl = bvv[e] + wv[0][e] * v2[e] + wv[1][e] * v1[e] + wv[2][e] * v0[e];
                o[e] = cgt / (1.f + __expf(-cgt)) * cvl;
                g2[e] = g1[e]; g1[e] = g0[e]; v2[e] = v1[e]; v1[e] = v0[e];
            }
            v4u w; w.x = pk2(o[0], o[1]); w.y = pk2(o[2], o[3]); w.z = pk2(o[4], o[5]); w.w = pk2(o[6], o[7]);
            *(v4u*)(H + (size_t)t * DFF + tile * 128 + g8 * 8) = w;
        }
    }
}


namespace att {
constexpr float SCALE = 0.08838834764831845f, LOG2E = 1.4426950408889634f, C2 = LOG2E * SCALE, THR2 = 8.f * LOG2E;
constexpr int NW = 8, QBLK = 32, KVBLK = 64, QB = NW * QBLK, D = 128;
constexpr int SHM_V = KVBLK * D * 2, SHM_K = KVBLK * D * 2;
constexpr int WS_OFF = 2 * SHM_V + 2 * SHM_K, C2_OFF = WS_OFF + NW * 64 * 4, LDS_NEED = C2_OFF + SEQ * 4;
constexpr int KS = ATT_N, OS = DM;
typedef float f32x16 __attribute__((ext_vector_type(16)));
typedef unsigned u32x4 __attribute__((ext_vector_type(4)));

#define KSWZ(row, colB) ((row) * 256 + ((colB) ^ (((row) & 7) << 4)))
#define SBAR() __builtin_amdgcn_sched_barrier(0)
__device__ __forceinline__ int v_st(int k, int c) { const int kk = (k & ~0xC) | ((k & 4) << 1) | ((k & 8) >> 1); return ((kk >> 3) * 4 + (c >> 5)) * 512 + ((kk & 7) * 32 + (c & 31)) * 2; }
__device__ __forceinline__ int v_rd_base(int lane) { return ((lane & 3) << 3) | (((lane >> 2) & 3) << 6) | (((lane >> 4) & 1) << 5) | (((lane >> 5) & 1) << 8); }
constexpr int v_rd_off(int d0, int ks, int half) { return d0 * 512 + ks * 4096 + half * 2048; }
__device__ __forceinline__ int crow(int r, int hi) { return (r & 3) + 8 * (r >> 2) + 4 * hi; }
__device__ __forceinline__ unsigned cvtpk(float lo, float hi) { unsigned r; asm volatile("v_cvt_pk_bf16_f32 %0, %1, %2" : "=v"(r) : "v"(lo), "v"(hi)); return r; }
__device__ __forceinline__ bf16x8 load8(const bf16* p) { return *reinterpret_cast<const bf16x8*>(p); }
__device__ __forceinline__ void mask_tile(f32x16& p0, f32x16& p1, int dq, unsigned W) {
    const float NEG = -__builtin_inff();
#pragma unroll
    for (int r = 0; r < 16; ++r) {
        const int c = (r & 3) + 8 * (r >> 2);
        if ((unsigned)(dq - c) >= W) p0[r] = NEG;
        if ((unsigned)(dq - c - 32) >= W) p1[r] = NEG;
    }
}
template <int MODE>
__device__ __forceinline__ void partialSM(f32x16& p0, f32x16& p1, float& m_reg, float& mn, float& alpha, const LAS float* c2k  , float ct2) {
    if constexpr (MODE == 0) {
#pragma unroll
        for (int g = 0; g < 4; ++g) { const f32x4 b0 = *(const LAS f32x4*)(c2k + 8 * g), b1 = *(const LAS f32x4*)(c2k + 32 + 8 * g);
#pragma unroll
            for (int e = 0; e < 4; ++e) { p0[4 * g + e] = fmaf(p0[4 * g + e], C2, ct2 - b0[e]); p1[4 * g + e] = fmaf(p1[4 * g + e], C2, ct2 - b1[e]); } }
    } else {
#pragma unroll
        for (int r = 0; r < 16; ++r) { p0[r] *= C2; p1[r] *= C2; }
    }
    float pmax = p0[0];
#pragma unroll
    for (int r = 1; r < 16; ++r) pmax = fmaxf(pmax, p0[r]);
#pragma unroll
    for (int r = 0; r < 16; ++r) pmax = fmaxf(pmax, p1[r]);
    { auto rr = __builtin_amdgcn_permlane32_swap(__float_as_uint(pmax), __float_as_uint(pmax), false, false);
      pmax = fmaxf(__uint_as_float(rr[0]), __uint_as_float(rr[1])); }
    if (__builtin_expect(__all((pmax - m_reg) <= THR2), 1)) { mn = m_reg; alpha = 1.f; }
    else { mn = fmaxf(m_reg, pmax); alpha = __builtin_amdgcn_exp2f(m_reg - mn); m_reg = mn; }
#pragma unroll
    for (int r = 0; r < 16; ++r) { p0[r] -= mn; p1[r] -= mn; }
#pragma unroll
    for (int r = 0; r < 16; ++r) p0[r] = __builtin_amdgcn_exp2f(p0[r]);
}
__device__ __forceinline__ void finishSM(f32x16& p0, f32x16& p1, float alpha, float& l_reg, bf16x8& pa0, bf16x8& pa1, bf16x8& pa2, bf16x8& pa3) {
#pragma unroll
    for (int r = 0; r < 16; ++r) p1[r] = __builtin_amdgcn_exp2f(p1[r]);
    float ps = 0;
#pragma unroll
    for (int r = 0; r < 16; ++r) ps += p0[r];
#pragma unroll
    for (int r = 0; r < 16; ++r) ps += p1[r];
    { auto rr = __builtin_amdgcn_permlane32_swap(__float_as_uint(ps), __float_as_uint(ps), false, false);
      ps = __uint_as_float(rr[0]) + __uint_as_float(rr[1]); }
    l_reg = l_reg * alpha + ps;
#define PK4(P, B_, OUT) do { unsigned a0 = cvtpk(P[B_+0], P[B_+1]), a1 = cvtpk(P[B_+2], P[B_+3]);                          \
        unsigned b0 = cvtpk(P[B_+4], P[B_+5]), b1 = cvtpk(P[B_+6], P[B_+7]);                                             \
        auto r0 = __builtin_amdgcn_permlane32_swap(a0, b0, false, false); auto r1 = __builtin_amdgcn_permlane32_swap(a1, b1, false, false); \
        u32x4 w = {r0[0], r1[0], r0[1], r1[1]}; OUT = *reinterpret_cast<bf16x8*>(&w); } while (0)
    PK4(p0, 0, pa0); PK4(p0, 8, pa1); PK4(p1, 0, pa2); PK4(p1, 8, pa3);
#undef PK4
}
template <int KB, bool SK>
__device__ __forceinline__ void qkt(f32x16& p0, f32x16& p1, const char* K_lds, int r32, int hi, const bf16x8* qr, bool act) {
    if (SK && !act) { const float NEG = -__builtin_inff();
#pragma unroll
        for (int r = 0; r < 16; ++r) { p0[r] = NEG; p1[r] = NEG; } return; }
    p0 = f32x16{}; p1 = f32x16{};
    const char* kb[4];
#pragma unroll
    for (int dd = 0; dd < 4; ++dd) kb[dd] = K_lds + KB * SHM_K + KSWZ(r32, (dd * 16 + hi * 8) * 2);
#pragma unroll
    for (int d0 = 0; d0 < 8; ++d0) { const char* a = kb[d0 & 3] + (d0 >> 2) * 128;
        bf16x8 b0 = *reinterpret_cast<const bf16x8*>(a);
        bf16x8 b1 = *reinterpret_cast<const bf16x8*>(a + 32 * 256);
        p0 = __builtin_amdgcn_mfma_f32_32x32x16_bf16(b0, qr[d0], p0, 0, 0, 0);
        p1 = __builtin_amdgcn_mfma_f32_32x32x16_bf16(b1, qr[d0], p1, 0, 0, 0); }
}
template <int VB, bool SK>
__device__ __forceinline__ void pv_tile(f32x16* o, int vb0, bf16x8 pa0, bf16x8 pa1, bf16x8 pa2, bf16x8 pa3, bool act) {
    if (SK && !act) return;
#define TRRD(dst, off) asm volatile("ds_read_b64_tr_b16 %0, %1 offset:%2" : "=&v"(dst) : "v"(vb0), "i"(off) : "memory")
#define PV_D0(d0) do { s16x4 l0, l1, l2, l3, h0, h1, h2, h3; constexpr int b_ = VB * SHM_V + v_rd_off(d0, 0, 0); \
        TRRD(l0, b_); TRRD(h0, b_ + 2048); TRRD(l1, b_ + 4096); TRRD(h1, b_ + 6144); TRRD(l2, b_ + 8192); TRRD(h2, b_ + 10240); TRRD(l3, b_ + 12288); TRRD(h3, b_ + 14336); \
        asm volatile("s_waitcnt lgkmcnt(0)" ::: "memory"); SBAR();   \
        o[d0] = __builtin_amdgcn_mfma_f32_32x32x16_bf16(pa0, (bf16x8){l0[0], l0[1], l0[2], l0[3], h0[0], h0[1], h0[2], h0[3]}, o[d0], 0, 0, 0);   \
        o[d0] = __builtin_amdgcn_mfma_f32_32x32x16_bf16(pa1, (bf16x8){l1[0], l1[1], l1[2], l1[3], h1[0], h1[1], h1[2], h1[3]}, o[d0], 0, 0, 0);   \
        o[d0] = __builtin_amdgcn_mfma_f32_32x32x16_bf16(pa2, (bf16x8){l2[0], l2[1], l2[2], l2[3], h2[0], h2[1], h2[2], h2[3]}, o[d0], 0, 0, 0);   \
        o[d0] = __builtin_amdgcn_mfma_f32_32x32x16_bf16(pa3, (bf16x8){l3[0], l3[1], l3[2], l3[3], h3[0], h3[1], h3[2], h3[3]}, o[d0], 0, 0, 0); } while (0)
    PV_D0(0); PV_D0(1); PV_D0(2); PV_D0(3);
#undef PV_D0
#undef TRRD
}

struct BlockRef { const bf16* Q; const bf16* K; const bf16* V; bf16* O; int P0; float m0; };
struct Seam { bf16x8 qr[8]; bf16x8 st_v0, st_v1, st_k0, st_k1; };
__device__ __forceinline__ int swa_jlo(int P0, int W) { const int lowk = P0 - W + 1; return lowk > 0 ? lowk / KVBLK : 0; }
#define ROW(p, k0, rr) ((p) + (size_t)((k0) + (rr)) * KS + sc)
#define VMW() asm volatile("s_waitcnt vmcnt(0)" ::: "memory")
#define VMWN(n) asm volatile("s_waitcnt vmcnt(%0)" :: "i"(n) : "memory")
#define SLOAD_H(Kp, Vp, k0) do { S.st_v0 = load8(ROW(Vp, k0, sr)); S.st_v1 = load8(ROW(Vp, k0, 32 + sr));              \
                         S.st_k0 = load8(ROW(Kp, k0, sr)); S.st_k1 = load8(ROW(Kp, k0, 32 + sr)); } while (0)
#define SWRITE_HK(bf) do { *(bf16x8*)(K_lds + (bf) * SHM_K + kws) = S.st_k0; *(bf16x8*)(K_lds + (bf) * SHM_K + kws + 32 * 256) = S.st_k1; } while (0)
#define SWRITE_HV(bf) do { *(bf16x8*)(V_lds + (bf) * SHM_V + vst0) = S.st_v0; *(bf16x8*)(V_lds + (bf) * SHM_V + vst1) = S.st_v1; } while (0)
#define SWRITE_H(bf) do { SWRITE_HV(bf); SWRITE_HK(bf); } while (0)
template <int W>
__device__ __forceinline__ void prime(const BlockRef& cur, char* lds, Seam& S) {
    int tid_l = threadIdx.x; asm volatile("" : "+v"(tid_l));
    const int tid = tid_l, wid = __builtin_amdgcn_readfirstlane(tid >> 6), lane = tid & 63, r32 = lane & 31, hi = lane >> 5;
    const int sr = tid >> 4, sc = (tid & 15) * 8, kws = KSWZ(sr, sc * 2); char* K_lds = lds + 2 * SHM_V;
    const int kb0 = swa_jlo(cur.P0, W) * KVBLK;
#pragma unroll
    for (int d0 = 0; d0 < 8; ++d0) S.qr[d0] = load8(cur.Q + (size_t)(wid * QBLK + r32) * KS + d0 * 16 + hi * 8);
    SLOAD_H(cur.K, cur.V, kb0); VMW(); SWRITE_HK(0);
    __syncthreads();
}
template <int MODE, int W, bool SK>
__device__ __forceinline__ void block(const BlockRef& cur, const BlockRef& nxt, char* lds, Seam& S) {
    int tid_l = threadIdx.x; asm volatile("" : "+v"(tid_l));
    const int tid = tid_l, wid = __builtin_amdgcn_readfirstlane(tid >> 6), lane = tid & 63, r32 = lane & 31, hi = lane >> 5;
    const int j_lo = swa_jlo(cur.P0, W);
    const int j_hi = (cur.P0 + QB - 1) / KVBLK + 1;
    const int NT = j_hi - j_lo;
    const int kbn = swa_jlo(nxt.P0, W) * KVBLK;
    const int qlo = cur.P0 + wid * QBLK, qm = qlo + r32 - 4 * hi;
    char* V_lds = lds; char* K_lds = lds + 2 * SHM_V;
    float* ws = (float*)(lds + WS_OFF) + wid * 64; float* li_l = ws, * al_l = ws + 32;
    const LAS float* c2 = (const LAS float*)((LAS unsigned char*)lds + C2_OFF);
    const float ct2 = (MODE == 0) ? c2[qlo + r32] : 0.f;
    float m_reg = (MODE == 0) ? -1e30f : cur.m0, l_reg = (MODE == 0) ? 0.f : 1.f; f32x16 o[4] = {};
    const int sr = tid >> 4, sc = (tid & 15) * 8, vst0 = v_st(sr, sc), vst1 = v_st(32 + sr, sc), kws = KSWZ(sr, sc * 2);
    const int vb0 = (int)(uintptr_t)V_lds + v_rd_base(lane);
    const bf16* Kh = cur.K; const bf16* Vh = cur.V;
#define RESC(a) do { if (__any((a) < 1.f)) { if (hi == 0) al_l[r32] = (a); asm volatile("s_waitcnt lgkmcnt(0)" ::: "memory");              \
                     for (int d_ = 0; d_ < 4; ++d_) for (int r = 0; r < 16; ++r) o[d_][r] *= al_l[crow(r, hi)]; } } while (0)
#define KBASE(t) ((j_lo + (t)) * KVBLK)
#define ACT(t) (KBASE(t) <= qlo + QBLK - 1 && KBASE(t) + KVBLK - 1 >= qlo - W + 1)
#define MASKT(P0_, P1_, t) do { const int kb_ = KBASE(t); if ((!SK || ACT(t)) && (kb_ + KVBLK - 1 > qlo || kb_ <= qlo + QBLK - 1 - W)) mask_tile(P0_, P1_, qm - kb_, (unsigned)W); } while (0)
#define PSM(PX0, PX1, mnX, alX, t) partialSM<MODE>(PX0, PX1, m_reg, mnX, alX, c2 + KBASE(t) + 4 * hi, ct2)
    constexpr int NQL = 8;
#define SEAM_K0() do { VMWN(NQL); SWRITE_HK(0); SBAR(); } while (0)
    f32x16 pA0, pA1, pB0, pB1; float mnA, mnB, alA, alB; bf16x8 pa0, pa1, pa2, pa3;
    SWRITE_HV(0); SBAR();
    if (NT > 1) { SLOAD_H(Kh, Vh, KBASE(1)); }
    SBAR(); qkt<0, SK>(pA0, pA1, K_lds, r32, hi, S.qr, ACT(0));
    MASKT(pA0, pA1, 0); PSM(pA0, pA1, mnA, alA, 0);
    if (NT > 1) { VMW(); SWRITE_H(1); }
    __syncthreads();
#define HALF_STEP(PX0, PX1, mnX, alX, PY0, PY1, alY, t, KB, VB, SB) do {                                                      \
        SBAR(); qkt<KB, SK>(PX0, PX1, K_lds, r32, hi, S.qr, ACT(t));                                             \
        finishSM(PY0, PY1, alY, l_reg, pa0, pa1, pa2, pa3); SBAR();                                                           \
        if ((t) + 1 < NT) { SLOAD_H(Kh, Vh, KBASE((t) + 1)); SBAR(); }                                               \
        pv_tile<VB, SK>(o, vb0, pa0, pa1, pa2, pa3, ACT((t) - 1)); MASKT(PX0, PX1, (t)); PSM(PX0, PX1, mnX, alX, (t));                                        \
        __syncthreads();                                                                                                      \
        if ((t) + 1 < NT) { VMW(); SWRITE_H(SB); }                                                                          \
        RESC(alX); __syncthreads(); } while (0)
    for (int t = 1; t + 1 < NT; t += 2) {
        HALF_STEP(pB0, pB1, mnB, alB, pA0, pA1, alA, t, 1, 0, 0);
        HALF_STEP(pA0, pA1, mnA, alA, pB0, pB1, alB, t + 1, 0, 1, 1);
    }
    const bool even = (NT & 1) == 0;
    if (even) { SBAR(); qkt<1, SK>(pB0, pB1, K_lds, r32, hi, S.qr, ACT(NT - 1)); SBAR(); }
    SLOAD_H(nxt.K, nxt.V, kbn); SBAR();
#pragma unroll
    for (int d0 = 0; d0 < 8; ++d0) S.qr[d0] = load8(nxt.Q + (size_t)(wid * QBLK + r32) * KS + d0 * 16 + hi * 8);
    SBAR();
    finishSM(pA0, pA1, alA, l_reg, pa0, pa1, pa2, pa3); SBAR();
    pv_tile<0, SK>(o, vb0, pa0, pa1, pa2, pa3, ACT(even ? NT - 2 : NT - 1));
    if (even) { MASKT(pB0, pB1, NT - 1); PSM(pB0, pB1, mnB, alB, NT - 1); __syncthreads(); RESC(alB);
        finishSM(pB0, pB1, alB, l_reg, pa0, pa1, pa2, pa3); SBAR(); pv_tile<1, SK>(o, vb0, pa0, pa1, pa2, pa3, ACT(NT - 1)); }
    SBAR(); SEAM_K0();
    if (hi == 0) li_l[r32] = l_reg; asm volatile("s_waitcnt lgkmcnt(0)" ::: "memory");
    float rli[16];
#pragma unroll
    for (int r = 0; r < 16; ++r) rli[r] = __builtin_amdgcn_rcpf(li_l[crow(r, hi)]);
    bf16* Ow = cur.O + (size_t)(wid * QBLK) * OS;
#pragma unroll
    for (int r = 0; r < 16; ++r) { const int orow = crow(r, hi);
#pragma unroll
        for (int d0 = 0; d0 < 4; ++d0) { const float v = o[d0][r] * rli[r];
            const float vn = __shfl_xor(v, 1);
            if ((r32 & 1) == 0) *(unsigned*)(Ow + (size_t)orow * OS + d0 * 32 + r32) = cvtpk(v, vn); } }
    __syncthreads();
#undef RESC
#undef KBASE
#undef ACT
#undef MASKT
#undef PSM
#undef SEAM_K0
#undef HALF_STEP
}
#undef ROW
#undef VMW
#undef VMWN
#undef SLOAD_H
#undef SWRITE_HK
#undef SWRITE_HV
#undef SWRITE_H

__device__ __forceinline__ void fox_ctable(const float* GATES, int b, int h, char* lds) {
    LAS float* c2 = (LAS float*)((LAS unsigned char*)lds + C2_OFF);
    LAS float* wsum = (LAS float*)((LAS unsigned char*)lds + WS_OFF);
    int tid_l = threadIdx.x; asm volatile("" : "+v"(tid_l));
    const int tid = tid_l, lane = tid & 63, wid = tid >> 6;
    float v[8]; float s = 0.f;
#pragma unroll
    for (int e = 0; e < 8; ++e) { v[e] = log_sigmoid(GATES[(size_t)(b * SEQ + tid * 8 + e) * 16 + h]) * LOG2E; s += v[e]; v[e] = s; }
    float inc = s;
#pragma unroll
    for (int o = 1; o < 64; o <<= 1) { const float t = __shfl_up(inc, o); if (lane >= o) inc += t; }
    if (lane == 63) wsum[wid] = inc;
    __syncthreads();
    float base = inc - s;
    for (int w = 0; w < wid; ++w) base += wsum[w];
#pragma unroll
    for (int e = 0; e < 8; ++e) c2[tid * 8 + e] = base + v[e];
    __syncthreads();
}

__device__ __forceinline__ void attn_phase(const bf16* PROJ, const float* GATES, const float* sinks, bf16* HEADS, char* lds, int bx, int G) {
    constexpr int NQB = SEQ / QB;
    for (int L = bx; L < NBATCH * FOXH * (NQB / 2); L += G) {
        const int bh = L / (NQB / 2), x = L % (NQB / 2), b = bh / FOXH, h = bh % FOXH;
        fox_ctable(GATES, b, h, lds);
        const bf16* base = PROJ + (size_t)b * SEQ * KS;
        BlockRef r0, r1;
        r0.Q = base + (size_t)(x * QB) * KS + A_FQ + h * 128; r0.K = base + A_FK + h * 128; r0.V = base + A_FV + h * 128; r0.O = HEADS + ((size_t)b * SEQ + x * QB) * OS + h * 128; r0.P0 = x * QB; r0.m0 = 0.f;
        const int y = NQB - 1 - x;
        r1 = r0; r1.Q = base + (size_t)(y * QB) * KS + A_FQ + h * 128; r1.O = HEADS + ((size_t)b * SEQ + y * QB) * OS + h * 128; r1.P0 = y * QB;
        Seam S;
        prime<SEQ>(r0, lds, S);
        BlockRef cur = r0, nxt = r1;
        for (int pass = 0; pass < 2; ++pass) { block<0, SEQ, false>(cur, nxt, lds, S); cur = nxt; }
    }
    for (int L = bx; L < NBATCH * SWAQ * (NQB / 2); L += G) {
        const int bh = L / (NQB / 2), x = L % (NQB / 2), b = bh / SWAQ, h = bh % SWAQ, kvh = h / (SWAQ / SWAKV);
        const bf16* base = PROJ + (size_t)b * SEQ * KS;
        BlockRef r0, r1;
        r0.Q = base + (size_t)(2 * x * QB) * KS + A_SQ + h * 128; r0.K = base + A_SK + kvh * 128; r0.V = base + A_SV + kvh * 128; r0.O = HEADS + ((size_t)b * SEQ + 2 * x * QB) * OS + 1024 + h * 128; r0.P0 = 2 * x * QB;
        r0.m0 = sinks[h] * LOG2E;
        r1 = r0; r1.Q = r0.Q + (size_t)QB * KS; r1.O = r0.O + (size_t)QB * OS; r1.P0 = r0.P0 + QB;
        Seam S;
        prime<SWAW>(r0, lds, S);
        BlockRef cur = r0, nxt = r1;
        for (int pass = 0; pass < 2; ++pass) { block<1, SWAW, true>(cur, nxt, lds, S); cur = nxt; }
    }
}
#undef KSWZ
#undef SBAR
}
#ifndef MLSTM_PHASE
#define MLSTM_PHASE ;
#endif

__global__ void __launch_bounds__(NTHREADS, 2) mega(Args a) {
    extern __shared__ __attribute__((aligned(16))) unsigned char lds_raw[];
    LAS unsigned char* lds = (LAS unsigned char*)lds_raw;
    const int tid = threadIdx.x, lane = tid & 63, wave = __builtin_amdgcn_readfirstlane(tid >> 6);
    const int G = gridDim.x, bx = blockIdx.x;
    const int vcu = (G % 8 == 0) ? (bx % 8) * (G / 8) + bx / 8 : bx;
    for (int u = tid; u < (LDS_BYTES - LDSCTL_OFF) / 4; u += NTHREADS) ((LAS unsigned*)(lds + LDSCTL_OFF))[u] = 0u;
    __syncthreads();
    unsigned char* ws = a.ws;
    gu32* ctl = (gu32*)(ws + WS_CTL);
    volatile LAS unsigned* MISC = (volatile LAS unsigned*)(lds + LDSCTL_OFF);
    XcdBarrier bar = xcd_barrier_post((unsigned*)ctl + CW_BAR + a.bar_region * BAR_STRIDE, MISC + 8);
    const int lo = a.ph_lo, hi = a.ph_hi;
#define IN(k) (lo <= (k) && (k) < hi)
#define SEAM(k) do { if (IN(k) && IN((k) + 1)) xcd_barrier(bar); } while (0)
    float* X = (float*)(ws + WS_X); bf16* XB = (bf16*)(ws + WS_XB); bf16* PROJ = (bf16*)(ws + WS_PROJ); bf16* HEADS = (bf16*)(ws + WS_HEADS);
    bf16* UB = (bf16*)(ws + WS_R1); bf16* HB = (bf16*)(ws + WS_H); float* GATES = (float*)(ws + WS_GATES);

    if (IN(0)) p0_prologue(a, lds, vcu, G, wave, lane, tid);
    SEAM(0);
    for (int layer = 0; layer < DEPTH; ++layer) {
        const int j = layer >> 1, odd = layer & 1, pb = 1 + layer * 8;
        const int NGW = G * NWAVES, NGT = G * NTHREADS;
#define LANE_VARS int tl = threadIdx.x; asm volatile("" : "+v"(tl)); const int lane = tl & 63, gw = vcu * NWAVES + __builtin_amdgcn_readfirstlane(tl >> 6), gt = vcu * NTHREADS + tl; (void)lane; (void)gw; (void)gt;
        if (IN(pb)) {
            LANE_VARS
            const bf16* WG = (const bf16*)(ws + WS_WG) + (size_t)(odd ? 2 + j : j) * 32 * DM;
            gates_phase(XB, WG, odd ? a.in[6] + (size_t)j * ML_IN + 6144 : a.in[2] + (size_t)j * ATT_IN + 3072, odd ? 16 : 8, GATES, gw, NGW, lane);
            const int N = odd ? ML_N : ATT_N;
            pg8::Gemm g{XB, odd ? (const bf16*)(ws + WS_WMIN) + (size_t)j * ML_N * DM : (const bf16*)(ws + WS_WAIN) + (size_t)j * ATT_N * DM, MTOK, N, DM};
            pg8::StaticOrder S; S.init(MTOK, N, G, bx);
            pg8::EpiProj E{PROJ, N, odd ? a.in[6] + (size_t)j * ML_IN : (const float*)(ws + WS_BIASA) + (size_t)j * ATT_N, odd ? 0 : A_SQ / 256, odd ? 0 : A_SV / 256, (const float*)(ws + WS_ROPE)};
            pg8::gemm_phase<pg8::EpiProj, pg8::StaticOrder, true, true>(lds, g, S, E);
        }
        SEAM(pb);
        if (IN(pb + 1)) {
#if !NAIVE_ATTN
            if (!odd) att::attn_phase(PROJ, GATES, a.in[3] + (size_t)j * SWAQ, HEADS, (char*)lds_raw, bx, G);
#endif
#if !NAIVE_MLSTM
            if (odd) MLSTM_PHASE
#endif
        }
        SEAM(pb + 1);
        if (IN(pb + 2)) {
            pg8::Gemm g{HEADS, odd ? (const bf16*)(ws + WS_WMOUT) + (size_t)j * DM * DM : (const bf16*)(ws + WS_WAOUT) + (size_t)j * DM * DM, MTOK, DM, DM};
            pg8::StaticOrder S; S.init(MTOK, DM, G, bx);
            pg8::EpiResid E{X, DM, DN_ALPHA};
            pg8::gemm_phase<pg8::EpiResid, pg8::StaticOrder, true, true>(lds, g, S, E);
        }
        SEAM(pb + 2);
        if (IN(pb + 3)) { LANE_VARS ln_phase(X, X, XB, a.in[12] + (size_t)layer * DM, a.in[13] + (size_t)layer * DM, gw, NGW, lane); }
        SEAM(pb + 3);
        if (IN(pb + 4)) {
            pg8::Gemm g{XB, (const bf16*)(ws + WS_WUP) + (size_t)layer * UPN * DM, MTOK, UPN, DM};
            pg8::StaticOrder S; S.init(MTOK, UPN, G, bx);
            pg8::EpiStoreBf16 E{UB, UPN};
            pg8::gemm_phase<pg8::EpiStoreBf16, pg8::StaticOrder, true, true>(lds, g, S, E);
        }
        SEAM(pb + 4);
        if (IN(pb + 5)) { LANE_VARS conv_phase(UB, HB, (const float*)(ws + WS_CONVW) + (size_t)layer * 3 * UPN, (const float*)(ws + WS_CONVB) + (size_t)layer * UPN, gt, NGT); }
        SEAM(pb + 5);
        if (IN(pb + 6)) {
            pg8::Gemm g{HB, (const bf16*)(ws + WS_WDN) + (size_t)layer * DM * DFF, MTOK, DM, DFF};
            pg8::StaticOrder S; S.init(MTOK, DM, G, bx);
            pg8::EpiResid E{X, DM, DN_ALPHA};
            pg8::gemm_phase<pg8::EpiResid, pg8::StaticOrder, true, true>(lds, g, S, E);
        }
        SEAM(pb + 6);
        if (IN(pb + 7)) { LANE_VARS const bool lastl = layer == DEPTH - 1; ln_phase(X, lastl ? a.out : X, lastl ? (bf16*)nullptr : XB, a.in[14] + (size_t)layer * DM, a.in[15] + (size_t)layer * DM, gw, NGW, lane); }
        SEAM(pb + 7);
    }
#undef IN
#undef LANE_VARS
#undef SEAM
}


#if NAIVE_ATTN || NAIVE_MLSTM
__global__ void naive_fox_c(const float* GATES, float* C) {
    const int i = blockIdx.x * blockDim.x + threadIdx.x; if (i >= NBATCH * FOXH) return;
    const int b = i / FOXH, h = i % FOXH; double acc = 0.0;
    for (int t = 0; t < SEQ; ++t) { acc += (double)log_sigmoid(GATES[(size_t)(b * SEQ + t) * 16 + h]); C[(size_t)i * SEQ + t] = (float)acc; }
}
__global__ __launch_bounds__(64) void naive_attn(const bf16* PROJ, const float* C, const float* sinks, bf16* HEADS) {
    __shared__ float lg[SEQ];
    const int lane = threadIdx.x, id = blockIdx.x;
    const int t = id % SEQ, hd = (id / SEQ) % 16, b = id / (SEQ * 16);
    const bool fox = hd < 8;
    const int qc = fox ? A_FQ + hd * 128 : A_SQ + (hd - 8) * 128, kc = fox ? A_FK + hd * 128 : A_SK + ((hd - 8) / 4) * 128, vc = fox ? A_FV + hd * 128 : A_SV + ((hd - 8) / 4) * 128;
    const bf16* qp = PROJ + (size_t)(b * SEQ + t) * ATT_N + qc;
    v4u q[16];
#pragma unroll
    for (int i = 0; i < 16; ++i) q[i] = *(const v4u*)(qp + 8 * i);
    const int lo = fox ? 0 : (t - (SWAW - 1) > 0 ? t - (SWAW - 1) : 0);
    const float ct = fox ? C[(size_t)(b * FOXH + hd) * SEQ + t] : 0.f;
    float mx = -3.0e38f;
    for (int s = lo + lane; s <= t; s += 64) {
        const bf16* kp = PROJ + (size_t)(b * SEQ + s) * ATT_N + kc; float dot = 0.f;
#pragma unroll
        for (int i = 0; i < 16; ++i) { const v4u kv = *(const v4u*)(kp + 8 * i);
#pragma unroll
            for (int e = 0; e < 4; ++e) dot += bflo(q[i][e]) * bflo(kv[e]) + bfhi(q[i][e]) * bfhi(kv[e]); }
        float lgt = dot * 0.08838834764831845f; if (fox) lgt += ct - C[(size_t)(b * FOXH + hd) * SEQ + s];
        lg[s - lo] = lgt; mx = fmaxf(mx, lgt);
    }
    mx = wave_max(mx);
    const float sink = fox ? 0.f : sinks[hd - 8];
    if (!fox) mx = fmaxf(mx, sink);
    float sum = 0.f;
    for (int s = lo + lane; s <= t; s += 64) { const float p = expf(lg[s - lo] - mx); lg[s - lo] = p; sum += p; }
    sum = wave_sum(sum); if (!fox) sum += expf(sink - mx);
    __syncthreads();
    float a0 = 0.f, a1 = 0.f;
    for (int s = lo; s <= t; ++s) { const float p = lg[s - lo]; const unsigned w = *(const unsigned*)(PROJ + (size_t)(b * SEQ + s) * ATT_N + vc + 2 * lane); a0 += p * bflo(w); a1 += p * bfhi(w); }
    const float inv = 1.f / sum;
    *(unsigned*)(HEADS + (size_t)(b * SEQ + t) * DM + hd * 128 + 2 * lane) = pk2(a0 * inv, a1 * inv);
}
__global__ __launch_bounds__(320) void naive_mlstm(const bf16* PROJ, const float* GATES, bf16* HEADS) {
    __shared__ float sk[128], sq[128], sdot[1];
    const int b = blockIdx.x / MLH, h = blockIdx.x % MLH, tid = threadIdx.x;
    float Cr[128];
#pragma unroll
    for (int d = 0; d < 128; ++d) Cr[d] = 0.f;
    float m = 0.f;
    for (int t = 0; t < SEQ; ++t) {
        const size_t row = (size_t)(b * SEQ + t);
        if (tid < 128) sk[tid] = bf2f(PROJ[row * ML_N + L_K + h * 128 + tid]) * 0.08838834764831845f;
        else if (tid < 256) sq[tid - 128] = bf2f(PROJ[row * ML_N + L_Q + h * 128 + tid - 128]);
        const float ip = GATES[row * 16 + h], fp = GATES[row * 16 + 8 + h];
        const float lf = log_sigmoid(fp), mn = fmaxf(lf + m, ip), fC = expf(lf + m - mn), iw = expf(ip - mn); m = mn;
        const float vv = tid < 256 ? bf2f(PROJ[row * ML_N + L_V + h * 256 + tid]) : 1.0f;
        __syncthreads();
        float num = 0.f; const float iv = iw * vv;
#pragma unroll
        for (int d = 0; d < 128; ++d) { Cr[d] = fC * Cr[d] + iv * sk[d]; num += Cr[d] * sq[d]; }
        if (tid == 256) sdot[0] = num;
        __syncthreads();
        if (tid < 256) { const float den = fmaxf(fabsf(sdot[0]), expf(-m)); const float hh = num / den; const float o = bf2f(PROJ[row * ML_N + L_O + h * 256 + tid]);
            HEADS[row * DM + h * 256 + tid] = (bf16)f2bf(hh / (1.f + expf(-o))); }
    }
}
#endif


static void launch_mega(Args a, int lo, int hi, int region, int grid, hipStream_t stream) {
    a.ph_lo = lo; a.ph_hi = hi; a.bar_region = region; a.pad = 0;
    hipLaunchKernelGGL(mega, dim3(grid), dim3(NTHREADS), LDS_BYTES, stream, a);
    const hipError_t le = hipPeekAtLastError();
    if (le != hipSuccess) fprintf(stderr, "kernel_launch: mega[%d,%d) failed: %s\n", lo, hi, hipGetErrorName(le));
}
extern "C" void kernel_launch(void* const* d_in, const int* in_sizes, int n_in, void* d_out, int out_size, void* d_ws, size_t ws_size, hipStream_t stream) {
    static int grid = 0;
    if (grid == 0) {
        if (n_in != 16 || in_sizes[0] != MTOK * DM || out_size != MTOK * DM || ws_size < WS_NEED) {
            fprintf(stderr, "kernel_launch: unexpected shapes (n_in %d, in0 %d, out %d, ws %zu < %zu); nothing launched\n", n_in, n_in > 0 ? in_sizes[0] : -1, out_size, ws_size, (size_t)WS_NEED); grid = -1; return; }
        int dev = 0, cus = 0, per_cu = 0;
        if (hipGetDevice(&dev) != hipSuccess || hipDeviceGetAttribute(&cus, hipDeviceAttributeMultiprocessorCount, dev) != hipSuccess) { fprintf(stderr, "kernel_launch: device query failed\n"); grid = -1; return; }
        if (hipFuncSetAttribute((const void*)mega, hipFuncAttributeMaxDynamicSharedMemorySize, LDS_BYTES) != hipSuccess) { fprintf(stderr, "kernel_launch: hipFuncSetAttribute failed\n"); grid = -1; return; }
        if (hipOccupancyMaxActiveBlocksPerMultiprocessor(&per_cu, (const void*)mega, NTHREADS, LDS_BYTES) != hipSuccess || per_cu < 1)
            fprintf(stderr, "kernel_launch: note: occupancy query reports %d workgroups per CU\n", per_cu);
        (void)hipGetLastError();
        grid = cus;
    }
    if (grid < 0) return;
    if (hipMemsetAsync((char*)d_ws + WS_CTL, 0, CTL_ZERO_BYTES, stream) != hipSuccess) { fprintf(stderr, "kernel_launch: memset failed\n"); return; }
    Args a{};
    for (int i = 0; i < 16; ++i) a.in[i] = (const float*)d_in[i];
    a.out = (float*)d_out; a.ws = (unsigned char*)d_ws;
    unsigned char* ws = (unsigned char*)d_ws; (void)ws;
    int region = 0, lo = 0;
    for (int layer = 0; layer < DEPTH; ++layer) {
        const int pb = 1 + layer * 8, j = layer >> 1; (void)j;
#if NAIVE_ATTN
        if ((layer & 1) == 0) {
            launch_mega(a, lo, pb + 1, region++, grid, stream); lo = pb + 2;
            hipLaunchKernelGGL(naive_fox_c, dim3(1), dim3(64), 0, stream, (const float*)(ws + WS_GATES), (float*)(ws + WS_FOXC));
            hipLaunchKernelGGL(naive_attn, dim3(NBATCH * 16 * SEQ), dim3(64), 0, stream, (const bf16*)(ws + WS_PROJ), (const float*)(ws + WS_FOXC), a.in[3] + (size_t)j * SWAQ, (bf16*)(ws + WS_HEADS));
        }
#endif
#if NAIVE_MLSTM
        if ((layer & 1) == 1) {
            launch_mega(a, lo, pb + 1, region++, grid, stream); lo = pb + 2;
            hipLaunchKernelGGL(naive_mlstm, dim3(NBATCH * MLH), dim3(320), 0, stream, (const bf16*)(ws + WS_PROJ), (const float*)(ws + WS_GATES), (bf16*)(ws + WS_HEADS));
        }
#endif
    }
    launch_mega(a, lo, 1 + DEPTH * 8, region++, grid, stream);
}
```

```cpp
#include <hip/hip_runtime.h>
#include <cstdio>
#include <cstdint>

constexpr int DM = 2048, NBATCH = 4, SEQ = 4096, MTOK = NBATCH * SEQ, DEPTH = 4;
constexpr int HD = 128, FOXH = 8, SWAQ = 8, SWAKV = 2, SWAW = 128;
constexpr int ATT_IN = 4616, ATT_N = 4608;
constexpr int ML_IN = 6160, ML_N = 6144;
constexpr int MLH = 8, MLDK = 128, MLDV = 256, MLCH = 64;
constexpr int DFF = 5632, UPN = 2 * DFF;
constexpr float LN_EPS = 1e-5f;
constexpr float DN_ALPHA = 1.6817928305074290f;
constexpr int A_FQ = 0, A_FK = 1024, A_FV = 2048, A_SQ = 3072, A_SK = 4096, A_SV = 4352;
constexpr int L_Q = 0, L_K = 1024, L_V = 2048, L_O = 4096;

#ifndef NAIVE_ATTN
#define NAIVE_ATTN 0
#endif
#ifndef NAIVE_MLSTM
#define NAIVE_MLSTM 0
#endif
namespace pg8 {
#define PG8_LAS __attribute__((address_space(3)))
typedef unsigned short bf16_t;
typedef short bf16x8 __attribute__((ext_vector_type(8)));
typedef float f32x4 __attribute__((ext_vector_type(4)));
typedef unsigned u32x4 __attribute__((ext_vector_type(4)));
constexpr int BM = 256, BK = 64, HALF = 128, HTB = HALF * BK * 2  , STAGE_BYTES = 8 * HTB, NXCD = 8, WGM = 8;

__host__ __device__ __forceinline__ int lds_byte(int r, int c) { const int st = (r >> 4) * 2 + (c >> 5), rr = r & 15, cc = c & 31, ob = rr * 64 + cc * 2; return st * 1024 + (ob ^ (((ob >> 9) & 1) << 5)); }
__host__ __device__ __forceinline__ void stage_rc(int b, int& R, int& C) { const int st = b / 1024, sb = b % 1024, swz = sb ^ (((sb >> 9) & 1) << 5); R = (st >> 1) * 16 + swz / 64; C = (st & 1) * 32 + (swz % 64) / 2; }
__host__ __device__ __forceinline__ int perm32(int rho) { const int n = rho >> 4, i = rho & 15; return 8 * (i >> 2) + 4 * n + (i & 3); }

struct Unit { int pm, pn; };
struct Gemm { const bf16_t* A; const bf16_t* Bt; int M, N, K; };

struct StaticOrder {
    int nM, nN, nwg, G, c;
    __host__ __device__ void init(int M, int N, int G_, int c_) { nM = M / BM; nN = N / BM; nwg = nM * nN; G = G_; c = c_; }
    __host__ __device__ bool next(int i, Unit& u) const {
        const long L = (long)i * G + c; if (L >= nwg) return false;
        int wgid = (int)L; { const int q = nwg / NXCD, r = nwg % NXCD, xcd = wgid % NXCD, off = wgid / NXCD; wgid = (xcd < r ? xcd * (q + 1) : r * (q + 1) + (xcd - r) * q) + off; }
        const int nig = WGM * nN, gid = wgid / nig, fm = gid * WGM, gsz = (nM - fm) < WGM ? (nM - fm) : WGM;
        u.pm = fm + ((wgid % nig) % gsz); u.pn = (wgid % nig) / gsz; return true;
    }
    __device__ __forceinline__ void a_ready(const Unit&) const {}
    __device__ __forceinline__ void done(const Unit&) const {}
};
__device__ __forceinline__ unsigned cvt_pk_bf16(float lo, float hi) { unsigned r; asm volatile("v_cvt_pk_bf16_f32 %0, %1, %2" : "=v"(r) : "v"(lo), "v"(hi)); return r; }
typedef float f32x2 __attribute__((ext_vector_type(2)));
typedef unsigned u32x2 __attribute__((ext_vector_type(2)));
struct EpiStoreBf16 {
    static constexpr bool PERM = true, AFTER_DRAIN = false;
    bf16_t* O; int ldc;
    __device__ __forceinline__ void operator()(const f32x4 (&acc)[2][2][4][2], const Unit& u, int wr, int wc, int fr, int fq) const {
        const int row0 = u.pm * BM + wr * 64 + fr, col0 = u.pn * BM + wc * 32 + 8 * fq;
#pragma unroll
        for (int ai = 0; ai < 2; ++ai)
#pragma unroll
            for (int m = 0; m < 4; ++m) { bf16_t* rowp = O + (size_t)(row0 + ai * HALF + m * 16) * ldc + col0;
#pragma unroll
                for (int bj = 0; bj < 2; ++bj) { const f32x4 v0 = acc[ai][bj][m][0], v1 = acc[ai][bj][m][1];
                    u32x4 w; w.x = cvt_pk_bf16(v0[0], v0[1]); w.y = cvt_pk_bf16(v0[2], v0[3]); w.z = cvt_pk_bf16(v1[0], v1[1]); w.w = cvt_pk_bf16(v1[2], v1[3]);
                    *(u32x4*)(rowp + bj * HALF) = w; } }
    }
};
struct EpiProj {
    static constexpr bool PERM = true, AFTER_DRAIN = false;
    bf16_t* O; int ldc; const float* bias; int rope_lo, rope_hi; const float* rope;
    __device__ __forceinline__ void operator()(const f32x4 (&acc)[2][2][4][2], const Unit& u, int wr, int wc, int fr, int fq) const {
        const int row0 = u.pm * BM + wr * 64 + fr, col0 = u.pn * BM + wc * 32 + 8 * fq;
        const bool rp = (u.pn >= rope_lo) && (u.pn < rope_hi);
        f32x4 bv[2][2];
#pragma unroll
        for (int bj = 0; bj < 2; ++bj)
#pragma unroll
            for (int n = 0; n < 2; ++n) bv[bj][n] = *(const f32x4*)(bias + col0 + bj * HALF + 4 * n);
        const int f0 = wc * 16 + 4 * fq;
#pragma unroll
        for (int ai = 0; ai < 2; ++ai)
#pragma unroll
            for (int m = 0; m < 4; ++m) { const int row = row0 + ai * HALF + m * 16; bf16_t* rowp = O + (size_t)row * ldc + col0;
                f32x4 cs0 = (f32x4){1.f, 0.f, 1.f, 0.f}, cs1 = cs0;
                if (rp) { const float* rt = rope + ((size_t)(row & (4096 - 1)) * 64 + f0) * 2; cs0 = *(const f32x4*)rt; cs1 = *(const f32x4*)(rt + 4); }
#pragma unroll
                for (int bj = 0; bj < 2; ++bj) { f32x4 v0 = acc[ai][bj][m][0] + bv[bj][0], v1 = acc[ai][bj][m][1] + bv[bj][1];
                    if (rp) { const f32x4 a = v0, b = v1;
                        v0[0] = a[0] * cs0[0] - a[1] * cs0[1]; v0[1] = a[1] * cs0[0] + a[0] * cs0[1];
                        v0[2] = a[2] * cs0[2] - a[3] * cs0[3]; v0[3] = a[3] * cs0[2] + a[2] * cs0[3];
                        v1[0] = b[0] * cs1[0] - b[1] * cs1[1]; v1[1] = b[1] * cs1[0] + b[0] * cs1[1];
                        v1[2] = b[2] * cs1[2] - b[3] * cs1[3]; v1[3] = b[3] * cs1[2] + b[2] * cs1[3]; }
                    u32x4 w; w.x = cvt_pk_bf16(v0[0], v0[1]); w.y = cvt_pk_bf16(v0[2], v0[3]); w.z = cvt_pk_bf16(v1[0], v1[1]); w.w = cvt_pk_bf16(v1[2], v1[3]);
                    *(u32x4*)(rowp + bj * HALF) = w; } }
    }
};
struct EpiResid {
    static constexpr bool PERM = false, AFTER_DRAIN = false;
    float* X; int ldc; float alpha;
    __device__ __forceinline__ void operator()(const f32x4 (&acc)[2][2][4][2], const Unit& u, int wr, int wc, int fr, int fq) const {
        const int row0 = u.pm * BM + wr * 64 + fr, col0 = u.pn * BM + wc * 32 + 4 * fq;
#pragma unroll
        for (int ai = 0; ai < 2; ++ai)
#pragma unroll
            for (int m = 0; m < 4; ++m) { float* rowp = X + (size_t)(row0 + ai * HALF + m * 16) * ldc + col0;
                f32x4 xv[2][2];
#pragma unroll
                for (int bj = 0; bj < 2; ++bj)
#pragma unroll
                    for (int n = 0; n < 2; ++n) xv[bj][n] = *(const f32x4*)(rowp + bj * HALF + n * 16);
#pragma unroll
                for (int bj = 0; bj < 2; ++bj)
#pragma unroll
                    for (int n = 0; n < 2; ++n) *(f32x4*)(rowp + bj * HALF + n * 16) = xv[bj][n] * alpha + acc[ai][bj][m][n];
                asm volatile("" ::: "memory"); }
    }
};

template <class Epi, class Sched, bool ALIGN_EPI = false, bool SP2 = false>
__device__ __forceinline__ void gemm_phase(PG8_LAS unsigned char* lds, const Gemm g, const Sched& S, const Epi& E) {
    int tid_l = threadIdx.x; asm volatile("" : "+v"(tid_l));
    const int tid = tid_l, wid = __builtin_amdgcn_readfirstlane(tid >> 6), lane = tid & 63, wr = wid >> 2, wc = wid & 3, fr = lane & 15, fq = lane >> 4;
    const int K = g.K, nt = K / BK;
    unsigned voffA[2], voffB[2];
#pragma unroll
    for (int i = 0; i < 2; ++i) { int R, C; stage_rc(tid * 16 + i * 8192, R, C); const int Rb = Epi::PERM ? ((R & ~31) + perm32(R & 31)) : R;
        voffA[i] = (unsigned)(R * K + C) * 2u; voffB[i] = (unsigned)(Rb * K + C) * 2u; }
    const size_t kstep = (size_t)(BK * 2);
    const size_t hstep = (size_t)HALF * K * 2;
    const size_t tstep = 2 * hstep;
    const unsigned ldsw = (unsigned)wid * 1024u;
    const int aoff = lds_byte(wr * 64 + fr, fq * 8), boff = lds_byte(wc * 32 + fr, fq * 8);
#define PG8_SA(b, h) (((b) * 2 + (h)) * HTB)
#define PG8_SB(b, h) ((4 + (b) * 2 + (h)) * HTB)
#define PG8_STAGE(bufoff, gbase, voff) do { _Pragma("unroll") for (int _i = 0; _i < 2; ++_i) \
        __builtin_amdgcn_global_load_lds((const unsigned*)((const char*)(gbase) + (voff)[_i]), (PG8_LAS unsigned*)(lds + (bufoff) + ldsw + _i * 8192), 16, 0, 0); } while (0)
#define PG8_LDA(dst, b, h) do { _Pragma("unroll") for (int m = 0; m < 4; ++m) _Pragma("unroll") for (int k = 0; k < 2; ++k) dst[m][k] = *(const PG8_LAS bf16x8*)(lds + PG8_SA(b, h) + aoff + m * 2048 + k * 1024); } while (0)
#define PG8_LDB(dst, b, h) do { _Pragma("unroll") for (int n = 0; n < 2; ++n) _Pragma("unroll") for (int k = 0; k < 2; ++k) dst[n][k] = *(const PG8_LAS bf16x8*)(lds + PG8_SB(b, h) + boff + n * 2048 + k * 1024); } while (0)
#define PG8_MMA(ai, bj, At, Bt) do { __builtin_amdgcn_s_setprio(1); _Pragma("unroll") for (int m = 0; m < 4; ++m) _Pragma("unroll") for (int n = 0; n < 2; ++n) _Pragma("unroll") for (int k = 0; k < 2; ++k) \
        acc[ai][bj][m][n] = __builtin_amdgcn_mfma_f32_16x16x32_bf16(Bt[n][k], At[m][k], acc[ai][bj][m][n], 0, 0, 0); __builtin_amdgcn_s_setprio(0); } while (0)
#define PG8_WAIT_V(n) asm volatile("s_waitcnt vmcnt(" #n ")" ::: "memory")
#define PG8_WAIT_L(n) asm volatile("s_waitcnt lgkmcnt(" #n ")" ::: "memory")
#define PG8_BAR __builtin_amdgcn_s_barrier()
#define PG8_SCHED __builtin_amdgcn_sched_barrier(0)
    Unit cur, nxt; int ui = 0;
    if (!S.next(0, cur)) return;
    f32x4 acc[2][2][4][2];
#pragma unroll
    for (int a = 0; a < 2; ++a)
#pragma unroll
        for (int b = 0; b < 2; ++b)
#pragma unroll
            for (int m = 0; m < 4; ++m)
#pragma unroll
                for (int n = 0; n < 2; ++n) acc[a][b][m][n] = (f32x4){0.f, 0.f, 0.f, 0.f};
    bf16x8 At[4][2], B0[2][2], B1[2][2];
    const char* cA = (const char*)g.A + (size_t)cur.pm * tstep; const char* cB = (const char*)g.Bt + (size_t)cur.pn * tstep;
    S.a_ready(cur);
    if constexpr (SP2) {
        PG8_STAGE(PG8_SB(0, 0), cB, voffB); PG8_STAGE(PG8_SB(0, 1), cB + hstep, voffB); PG8_STAGE(PG8_SA(0, 0), cA, voffA); PG8_STAGE(PG8_SA(0, 1), cA + hstep, voffA);
        if (wr == 1) PG8_BAR;
        PG8_WAIT_V(2); PG8_BAR;
        PG8_STAGE(PG8_SB(1, 0), cB + kstep, voffB); PG8_STAGE(PG8_SA(1, 0), cA + kstep, voffA); PG8_STAGE(PG8_SB(1, 1), cB + hstep + kstep, voffB);
        PG8_WAIT_V(6); PG8_BAR;
    } else {
        PG8_STAGE(PG8_SB(0, 0), cB, voffB); PG8_STAGE(PG8_SA(0, 0), cA, voffA); PG8_STAGE(PG8_SB(0, 1), cB + hstep, voffB); PG8_STAGE(PG8_SA(0, 1), cA + hstep, voffA);
        if (wr == 1) PG8_BAR;
        PG8_WAIT_V(4); PG8_BAR;
        PG8_STAGE(PG8_SB(1, 0), cB + kstep, voffB); PG8_STAGE(PG8_SA(1, 0), cA + kstep, voffA); PG8_STAGE(PG8_SB(1, 1), cB + hstep + kstep, voffB);
        PG8_WAIT_V(6); PG8_BAR;
    }
    for (;;) {
        const bool has_next = S.next(ui + 1, nxt);
        const char* nA = has_next ? (const char*)g.A + (size_t)nxt.pm * tstep : cA; const char* nB = has_next ? (const char*)g.Bt + (size_t)nxt.pn * tstep : cB;
        for (int t = 0; t < nt; t += 2) {
            const bool last = (t == nt - 2);
            const char* a1 = cA + (size_t)(t + 1) * kstep;
            const char* a2 = last ? nA : cA + (size_t)(t + 2) * kstep; const char* b2 = last ? nB : cB + (size_t)(t + 2) * kstep;
            const char* a3 = a2 + kstep; const char* b3 = b2 + kstep;
            if (last && has_next) S.a_ready(nxt);
            if constexpr (SP2) {
            PG8_LDB(B0, 0, 0); PG8_LDB(B1, 0, 1); PG8_SCHED; PG8_LDA(At, 0, 0); PG8_STAGE(PG8_SA(1, 1), a1 + hstep, voffA);
            PG8_WAIT_V(8); PG8_WAIT_L(0); PG8_BAR; PG8_MMA(0, 0, At, B0); PG8_MMA(0, 1, At, B1); PG8_BAR; PG8_SCHED;
            PG8_LDA(At, 0, 1); PG8_STAGE(PG8_SB(0, 0), b2, voffB); PG8_STAGE(PG8_SB(0, 1), b2 + hstep, voffB); PG8_STAGE(PG8_SA(0, 0), a2, voffA);
            PG8_WAIT_V(8); PG8_WAIT_L(0); PG8_BAR; PG8_MMA(1, 0, At, B0); PG8_MMA(1, 1, At, B1); PG8_BAR; PG8_SCHED;
            PG8_LDB(B0, 1, 0); PG8_LDB(B1, 1, 1); PG8_SCHED; PG8_LDA(At, 1, 0); PG8_STAGE(PG8_SA(0, 1), a2 + hstep, voffA);
            PG8_WAIT_V(8); PG8_WAIT_L(0); PG8_BAR; PG8_MMA(0, 0, At, B0); PG8_MMA(0, 1, At, B1); PG8_BAR; PG8_SCHED;
            PG8_LDA(At, 1, 1); PG8_STAGE(PG8_SB(1, 0), b3, voffB); PG8_STAGE(PG8_SB(1, 1), b3 + hstep, voffB); PG8_STAGE(PG8_SA(1, 0), a3, voffA);
            PG8_WAIT_V(8); PG8_WAIT_L(0); PG8_BAR; PG8_MMA(1, 0, At, B0); PG8_MMA(1, 1, At, B1); PG8_BAR; PG8_SCHED;
            } else {
            PG8_LDB(B0, 0, 0); PG8_SCHED; PG8_LDA(At, 0, 0); PG8_STAGE(PG8_SA(1, 1), a1 + hstep, voffA);
            PG8_WAIT_L(8); PG8_BAR; PG8_WAIT_L(0); PG8_MMA(0, 0, At, B0); PG8_BAR; PG8_SCHED;
            PG8_LDB(B1, 0, 1); PG8_STAGE(PG8_SB(0, 0), b2, voffB);
            PG8_BAR; PG8_WAIT_L(0); PG8_MMA(0, 1, At, B1); PG8_BAR;
            PG8_LDA(At, 0, 1); PG8_STAGE(PG8_SA(0, 0), a2, voffA);
            PG8_BAR; PG8_WAIT_L(0); PG8_MMA(1, 0, At, B0); PG8_BAR; PG8_SCHED;
            PG8_STAGE(PG8_SB(0, 1), b2 + hstep, voffB);
            PG8_WAIT_V(6); PG8_BAR; PG8_MMA(1, 1, At, B1); PG8_BAR;
            PG8_LDB(B0, 1, 0); PG8_SCHED; PG8_LDA(At, 1, 0); PG8_STAGE(PG8_SA(0, 1), a2 + hstep, voffA);
            PG8_WAIT_L(8); PG8_BAR; PG8_WAIT_L(0); PG8_MMA(0, 0, At, B0); PG8_BAR; PG8_SCHED;
            PG8_LDB(B1, 1, 1); PG8_STAGE(PG8_SB(1, 0), b3, voffB);
            PG8_BAR; PG8_WAIT_L(0); PG8_MMA(0, 1, At, B1); PG8_BAR;
            PG8_LDA(At, 1, 1); PG8_STAGE(PG8_SA(1, 0), a3, voffA);
            PG8_BAR; PG8_WAIT_L(0); PG8_MMA(1, 0, At, B0); PG8_BAR; PG8_SCHED;
            PG8_STAGE(PG8_SB(1, 1), b3 + hstep, voffB);
            PG8_WAIT_V(6); PG8_BAR; PG8_MMA(1, 1, At, B1); PG8_BAR;
            }
        }
        if constexpr (ALIGN_EPI) { if (wr == 0) PG8_BAR; }
        if constexpr (!Epi::AFTER_DRAIN) { E(acc, cur, wr, wc, fr, fq); S.done(cur); }
        if (!has_next) break;
#pragma unroll
        for (int a = 0; a < 2; ++a)
#pragma unroll
            for (int b = 0; b < 2; ++b)
#pragma unroll
                for (int m = 0; m < 4; ++m)
#pragma unroll
                    for (int n = 0; n < 2; ++n) acc[a][b][m][n] = (f32x4){0.f, 0.f, 0.f, 0.f};
        cur = nxt; cA = nA; cB = nB; ++ui;
        if constexpr (ALIGN_EPI) { if (wr == 1) PG8_BAR; }
    }
    PG8_WAIT_V(0);
    if constexpr (!ALIGN_EPI) { if (wr == 0) PG8_BAR; }
    PG8_BAR;
    if constexpr (Epi::AFTER_DRAIN) { E.fused(acc, cur, wr, wc, fr, fq, lds, wid, lane); S.done(cur); }
#undef PG8_SA
#undef PG8_SB
#undef PG8_STAGE
#undef PG8_LDA
#undef PG8_LDB
#undef PG8_MMA
#undef PG8_WAIT_V
#undef PG8_WAIT_L
#undef PG8_BAR
#undef PG8_SCHED
}
}

#define GAS __attribute__((address_space(1)))
#define LAS __attribute__((address_space(3)))
typedef unsigned short bf16;
typedef unsigned v4u __attribute__((ext_vector_type(4)));
typedef unsigned v2u __attribute__((ext_vector_type(2)));
typedef float f32x4 __attribute__((ext_vector_type(4)));
typedef float f32x16 __attribute__((ext_vector_type(16)));
typedef short bf16x8 __attribute__((ext_vector_type(8)));
typedef short s16x4 __attribute__((ext_vector_type(4)));
typedef GAS unsigned gu32;
#define RLX_AGENT __ATOMIC_RELAXED, __HIP_MEMORY_SCOPE_AGENT
#define LDS_WAIT() asm volatile("s_waitcnt lgkmcnt(0)" ::: "memory")
#define VM_WAIT() asm volatile("s_waitcnt vmcnt(0)" ::: "memory")
__device__ __forceinline__ unsigned f2bf(float f) { unsigned u = __builtin_bit_cast(unsigned, f); return (u + 0x7fffu + ((u >> 16) & 1u)) >> 16; }
__device__ __forceinline__ unsigned pk2(float lo, float hi) { return f2bf(lo) | (f2bf(hi) << 16); }
__device__ __forceinline__ float bf2f(unsigned short b) { return __builtin_bit_cast(float, (unsigned)b << 16); }
__device__ __forceinline__ float bflo(unsigned w) { return __builtin_bit_cast(float, w << 16); }
__device__ __forceinline__ float bfhi(unsigned w) { return __builtin_bit_cast(float, w & 0xffff0000u); }
__device__ __forceinline__ float wave_sum(float v) {
#pragma unroll
    for (int o = 1; o < 64; o <<= 1) v += __shfl_xor(v, o);
    return v;
}
__device__ __forceinline__ float wave_max(float v) {
#pragma unroll
    for (int o = 1; o < 64; o <<= 1) v = fmaxf(v, __shfl_xor(v, o));
    return v;
}
__device__ __forceinline__ float shfl_idx(float v, int src) { return __builtin_bit_cast(float, __builtin_amdgcn_ds_bpermute(src << 2, __builtin_bit_cast(int, v))); }
__device__ __forceinline__ float wave_sum_l(float v, int lane) {
#pragma unroll
    for (int o = 1; o < 64; o <<= 1) v += shfl_idx(v, lane ^ o);
    return v;
}
__device__ __forceinline__ float log_sigmoid(float x) {
    const float y = __builtin_amdgcn_exp2f(-fabsf(x) * 1.4426950408889634f);
    return fminf(x, 0.f) - __builtin_amdgcn_logf(1.f + y) * 0.6931471805599453f; }

#define XB_TMO      128
#define XB_XCNT(j)  (256  + 64 * (j))
#define XB_XSUB(j)  (1280 + 64 * (j))
#define XB_XGEN(j)  (2304 + 64 * (j))
#define XB_TOP      3328
#define XB_TOPGEN   3392
#define XCD_BAR_WORDS 3456
#define XB_SPIN_CAP (1u << 18)

__device__ __forceinline__ unsigned xb_ld(unsigned* p)              { return __hip_atomic_load(p, __ATOMIC_RELAXED, __HIP_MEMORY_SCOPE_AGENT); }
__device__ __forceinline__ unsigned xb_add(unsigned* p, unsigned v) { return __hip_atomic_fetch_add(p, v, __ATOMIC_RELAXED, __HIP_MEMORY_SCOPE_AGENT); }
__device__ __forceinline__ unsigned xb_xcc_id() { return (unsigned)__builtin_amdgcn_s_getreg((3 << 11) | 20) & 0xFu; }
#define XB_SPIN(cond, bar) do { unsigned _sp = 0; while (cond) { __builtin_amdgcn_s_sleep(1); \
    if ((++_sp & 255u) == 0u) { if (xb_ld(&(bar)[XB_TMO])) break; if (_sp > XB_SPIN_CAP) { atomicAdd(&(bar)[XB_TMO], 1u); break; } } } } while (0)

struct XcdBarrier {
    unsigned* bar; unsigned x;
    volatile LAS unsigned* st;
};

__device__ __forceinline__ XcdBarrier xcd_barrier_post(unsigned* bar, volatile LAS unsigned* st) {
    XcdBarrier b; b.bar = bar; b.x = xb_xcc_id(); b.st = st;
    if (threadIdx.x == 0) (void)xb_add(&bar[XB_XCNT(b.x)], 1u);
    return b;
}
__device__ __forceinline__ void xcd_barrier_complete(unsigned* bar, unsigned x, unsigned& nloc, unsigned& nx) {
    const unsigned G = gridDim.x * gridDim.y * gridDim.z;
    unsigned sum, cnt, mine, sp = 0u;
    for (;;) {
        sum = 0u; cnt = 0u; mine = 0u;
#pragma unroll
        for (unsigned j = 0; j < 16; ++j) { const unsigned c = xb_ld(&bar[XB_XCNT(j)]); sum += c; cnt += (c > 0u) ? 1u : 0u; mine = (j == x) ? c : mine; }
        if (sum == G) break;
        __builtin_amdgcn_s_sleep(1);
        if ((++sp & 255u) == 0u) { if (xb_ld(&bar[XB_TMO])) break; if (sp > XB_SPIN_CAP) { atomicAdd(&bar[XB_TMO], 1u); break; } }
    }
    nloc = mine > 0u ? mine : 1u; nx = cnt > 0u ? cnt : 1u;
}

__device__ __forceinline__ void xcd_barrier(const XcdBarrier& b) {
    asm volatile("s_waitcnt vmcnt(0)" ::: "memory");
    __syncthreads();
    if (threadIdx.x == 0) {
        unsigned* bar = b.bar;
        __builtin_amdgcn_s_waitcnt(0);
        unsigned nloc = b.st[0], nx = b.st[1];
        if (nloc == 0u) { xcd_barrier_complete(bar, b.x, nloc, nx); b.st[0] = nloc; b.st[1] = nx; }
        const unsigned old = xb_add(&bar[XB_XSUB(b.x)], 1u);
        const unsigned gen = old / nloc;
        if (old + 1u == (gen + 1u) * nloc) {
            __builtin_amdgcn_fence(__ATOMIC_RELEASE, "agent");
            asm volatile("s_waitcnt vmcnt(0)" ::: "memory");
            const unsigned og = xb_add(&bar[XB_TOP], 1u);
            const unsigned tg = og / nx;
            if (og + 1u == (tg + 1u) * nx) xb_add(&bar[XB_TOPGEN], 1u);
            else XB_SPIN(xb_ld(&bar[XB_TOPGEN]) == tg, bar);
            __builtin_amdgcn_fence(__ATOMIC_ACQUIRE, "agent");
            xb_add(&bar[XB_XGEN(b.x)], 1u);
            asm volatile("s_waitcnt vmcnt(0)" ::: "memory");
        } else {
            XB_SPIN(xb_ld(&bar[XB_XGEN(b.x)]) == gen, bar);
            __builtin_amdgcn_fence(__ATOMIC_ACQUIRE, "agent");
            asm volatile("s_waitcnt vmcnt(0)" ::: "memory");
        }
    }
    __syncthreads();
}

constexpr size_t MiB = 1u << 20;
constexpr size_t WS_CTL = 0, CTL_ZERO_BYTES = 1 * MiB;
constexpr size_t WS_ROPE = 1 * MiB;
constexpr size_t WS_BIASA = 3 * MiB;
constexpr size_t WS_CONVW = 3 * MiB + 65536;
constexpr size_t WS_CONVB = WS_CONVW + (size_t)4 * 3 * UPN * 4;
constexpr size_t WS_GATES = 4 * MiB;
constexpr size_t WS_WG = 5 * MiB;
constexpr size_t WS_WAIN = 6 * MiB, WS_WAOUT = 42 * MiB, WS_WMIN = 58 * MiB, WS_WMOUT = 106 * MiB, WS_WUP = 122 * MiB, WS_WDN = 298 * MiB;
constexpr size_t WS_X = 386 * MiB;
constexpr size_t WS_XB = 514 * MiB;
constexpr size_t WS_R1 = 578 * MiB;
constexpr size_t WS_PROJ = WS_R1, WS_HEADS = WS_R1 + 192 * MiB;
constexpr size_t WS_H = 930 * MiB;
constexpr size_t WS_END = 1106 * MiB;
constexpr size_t WS_FOXC = 1106 * MiB;
constexpr size_t WS_NEED = 1108 * MiB;
static_assert(WS_CONVB + (size_t)4 * UPN * 4 <= WS_GATES && WS_WAIN + (size_t)2 * ATT_N * DM * 2 <= WS_WAOUT && WS_WMIN + (size_t)2 * ML_N * DM * 2 <= WS_WMOUT &&
              WS_WUP + (size_t)4 * UPN * DM * 2 <= WS_WDN && WS_WDN + (size_t)4 * DM * DFF * 2 <= WS_X && WS_R1 + (size_t)MTOK * UPN * 2 <= WS_H && WS_H + (size_t)MTOK * DFF * 2 <= WS_END, "ws map");
constexpr int CW_BAR = 4096;
constexpr int BAR_STRIDE = 4096;

constexpr int RING_BYTES = 131072;
constexpr int LDSCTL_OFF = RING_BYTES;
constexpr int LDS_BYTES = 147456;
constexpr int NWAVES = 8, NTHREADS = 512;

enum { MAP_ID = 0, MAP_ATT = 1, MAP_ATTG = 2, MAP_MLG = 3, MAP_UP = 4 };
__device__ __forceinline__ int src_col(int kind, int n) {
    if (kind == MAP_ATT) {
        if (n < 3072) return n;
        if (n < 4352) { const int base = n < 4096 ? 3072 : 4096, sbase = n < 4096 ? 3080 : 4104, r = n - base, hh = r >> 7, p = r & 127; return sbase + hh * 128 + (p >> 1) + ((p & 1) << 6); }
        return 4360 + (n - 4352);
    }
    if (kind == MAP_ATTG) return n < 8 ? 3072 + n : -1;
    if (kind == MAP_MLG) return n < 16 ? 6144 + n : -1;
    if (kind == MAP_UP) { const int tile = n >> 8, w = n & 255; return w < 128 ? tile * 128 + w : DFF + tile * 128 + (w - 128); }
    return n;
}
__device__ __forceinline__ void tr_item(const float* W, int K, int Nsrc, int Nd, bf16* WT, int kind, LAS float* scr, int item, int lane) {
    const int nblk = Nd / 32, kb = item / nblk, nb = item % nblk, k0 = 64 * kb, n0 = 32 * nb;
    const int c = src_col(kind, n0 + (lane & 31));
#pragma unroll 8
    for (int i = 0; i < 32; ++i) { const int kk = 2 * i + (lane >> 5); scr[kk * 33 + (lane & 31)] = c >= 0 ? W[(size_t)(k0 + kk) * Nsrc + c] : 0.f; }
    LDS_WAIT(); asm volatile("" ::: "memory");
    const int ch = lane & 7;
#pragma unroll
    for (int j = 0; j < 4; ++j) { const int n = (lane >> 3) + 8 * j; const LAS float* s = scr + (8 * ch) * 33 + n;
        v4u o; o.x = pk2(s[0 * 33], s[1 * 33]); o.y = pk2(s[2 * 33], s[3 * 33]); o.z = pk2(s[4 * 33], s[5 * 33]); o.w = pk2(s[6 * 33], s[7 * 33]);
        *(GAS v4u*)(WT + (size_t)(n0 + n) * K + k0 + 8 * ch) = o; }
    LDS_WAIT(); asm volatile("" ::: "memory");
}

struct Args { const float* in[16]; float* out; unsigned char* ws; int ph_lo, ph_hi, bar_region, pad; };

__device__ __forceinline__ void p0_prologue(const Args& a, LAS unsigned char* lds, int vcu, int G, int wave, int lane, int tid) {
    unsigned char* ws = a.ws;
    LAS float* scr = (LAS float*)(lds + wave * 16384);
    const int gw = vcu * NWAVES + wave, NGW = G * NWAVES;
    constexpr int KB = DM / 64;
    constexpr int I_AIN = KB * (ATT_N / 32), I_G = KB * 1, I_OUT = KB * (DM / 32), I_MIN = KB * (ML_N / 32), I_UP = KB * (UPN / 32), I_DN = (DFF / 64) * (DM / 32);
    constexpr int NITEMS = 2 * (I_AIN + I_G + I_OUT + I_MIN + I_G + I_OUT) + 4 * (I_UP + I_DN);
    for (int it = gw; it < NITEMS; it += NGW) {
        int r = it;
        if (r < 4 * I_UP) { const int l = r / I_UP; tr_item(a.in[8] + (size_t)l * DM * UPN, DM, UPN, UPN, (bf16*)(ws + WS_WUP) + (size_t)l * UPN * DM, MAP_UP, scr, r % I_UP, lane); continue; } r -= 4 * I_UP;
        if (r < 4 * I_DN) { const int l = r / I_DN; tr_item(a.in[11] + (size_t)l * DFF * DM, DFF, DM, DM, (bf16*)(ws + WS_WDN) + (size_t)l * DM * DFF, MAP_ID, scr, r % I_DN, lane); continue; } r -= 4 * I_DN;
        if (r < 2 * I_AIN) { const int l = r / I_AIN; tr_item(a.in[1] + (size_t)l * DM * ATT_IN, DM, ATT_IN, ATT_N, (bf16*)(ws + WS_WAIN) + (size_t)l * ATT_N * DM, MAP_ATT, scr, r % I_AIN, lane); continue; } r -= 2 * I_AIN;
        if (r < 2 * I_MIN) { const int l = r / I_MIN; tr_item(a.in[5] + (size_t)l * DM * ML_IN, DM, ML_IN, ML_N, (bf16*)(ws + WS_WMIN) + (size_t)l * ML_N * DM, MAP_ID, scr, r % I_MIN, lane); continue; } r -= 2 * I_MIN;
        if (r < 2 * I_OUT) { const int l = r / I_OUT; tr_item(a.in[4] + (size_t)l * DM * DM, DM, DM, DM, (bf16*)(ws + WS_WAOUT) + (size_t)l * DM * DM, MAP_ID, scr, r % I_OUT, lane); continue; } r -= 2 * I_OUT;
        if (r < 2 * I_OUT) { const int l = r / I_OUT; tr_item(a.in[7] + (size_t)l * DM * DM, DM, DM, DM, (bf16*)(ws + WS_WMOUT) + (size_t)l * DM * DM, MAP_ID, scr, r % I_OUT, lane); continue; } r -= 2 * I_OUT;
        if (r < 2 * I_G) { const int l = r / I_G; tr_item(a.in[1] + (size_t)l * DM * ATT_IN, DM, ATT_IN, 32, (bf16*)(ws + WS_WG) + (size_t)l * 32 * DM, MAP_ATTG, scr, r % I_G, lane); continue; } r -= 2 * I_G;
        { const int l = r / I_G; tr_item(a.in[5] + (size_t)l * DM * ML_IN, DM, ML_IN, 32, (bf16*)(ws + WS_WG) + (size_t)(2 + l) * 32 * DM, MAP_MLG, scr, r % I_G, lane); }
    }
    { const float* x = a.in[0]; float* X = (float*)(ws + WS_X); bf16* XB = (bf16*)(ws + WS_XB);
      for (int m = gw; m < MTOK; m += NGW) {
          const GAS f32x4* xr = (const GAS f32x4*)(x + (size_t)m * DM) + lane; GAS f32x4* o = (GAS f32x4*)(X + (size_t)m * DM) + lane; GAS v2u* ob = (GAS v2u*)(XB + (size_t)m * DM) + lane;
#pragma unroll
          for (int j = 0; j < 8; ++j) { const f32x4 v = xr[64 * j]; o[64 * j] = v; v2u w; w.x = pk2(v.x, v.y); w.y = pk2(v.z, v.w); ob[64 * j] = w; } } }
    const int gt = (vcu * NTHREADS) + tid, NGT = G * NTHREADS;
    { float* rope = (float*)(ws + WS_ROPE);
      for (int i = gt; i < 4096 * 64; i += NGT) { const int pos = i >> 6, f = i & 63;
          const float inv = powf(10000.0f, -(float)f * (2.0f / 128.0f)); const float ang = (float)pos * inv;
          double ad = (double)ang; ad -= 6.283185307179586476925 * rint(ad * 0.15915494309189533577);
          const float ar = (float)ad; rope[2 * i] = cosf(ar); rope[2 * i + 1] = sinf(ar); } }
    { float* bA = (float*)(ws + WS_BIASA);
      for (int i = gt; i < 2 * ATT_N; i += NGT) { const int l = i / ATT_N, n = i % ATT_N; bA[i] = a.in[2][(size_t)l * ATT_IN + src_col(MAP_ATT, n)]; } }
    { float* cw = (float*)(ws + WS_CONVW); float* cb = (float*)(ws + WS_CONVB);
      for (int i = gt; i < 4 * 3 * UPN; i += NGT) { const int lj = i / UPN, n = i % UPN; cw[i] = a.in[9][(size_t)lj * UPN + src_col(MAP_UP, n)]; }
      for (int i = gt; i < 4 * UPN; i += NGT) { const int l = i / UPN, n = i % UPN; cb[i] = a.in[10][(size_t)l * UPN + src_col(MAP_UP, n)]; } }
}

__device__ __forceinline__ void gates_phase(const bf16* XB, const bf16* WG, const float* bsrc, int nb, float* GATES, int gw, int NGW, int lane) {
    typedef float f4 __attribute__((ext_vector_type(4)));
    for (int task = gw; task < MTOK / 16; task += NGW) {
        const int m0 = task * 16;
        f4 acc = (f4){0.f, 0.f, 0.f, 0.f};
        const bf16* ap = XB + (size_t)(m0 + (lane & 15)) * DM + 8 * (lane >> 4);
        const bf16* bp = WG + (size_t)(lane & 15) * DM + 8 * (lane >> 4);
#pragma unroll 8
        for (int k0 = 0; k0 < DM; k0 += 32) { const bf16x8 av = *(const bf16x8*)(ap + k0); const bf16x8 bv = *(const bf16x8*)(bp + k0); acc = __builtin_amdgcn_mfma_f32_16x16x32_bf16(av, bv, acc, 0, 0, 0); }
        const int g = lane & 15; const float bias = g < nb ? bsrc[g] : 0.f;
#pragma unroll
        for (int r = 0; r < 4; ++r) GATES[(size_t)(m0 + (lane >> 4) * 4 + r) * 16 + g] = acc[r] + bias;
    }
}

__device__ __forceinline__ void ln_phase(const float* X, float* Xo, bf16* XBo, const float* g, const float* b, int gw, int NGW, int lane) {
    f32x4 gv[8], bv[8];
#pragma unroll
    for (int j = 0; j < 8; ++j) { gv[j] = ((const f32x4*)g)[lane + 64 * j]; bv[j] = ((const f32x4*)b)[lane + 64 * j]; }
    for (int m = gw; m < MTOK; m += NGW) {
        const GAS f32x4* xr = (const GAS f32x4*)(X + (size_t)m * DM) + lane;
        f32x4 v[8]; float s = 0.f;
#pragma unroll
        for (int j = 0; j < 8; ++j) { v[j] = xr[64 * j]; s += (v[j].x + v[j].y) + (v[j].z + v[j].w); }
        const float mean = wave_sum_l(s, lane) * (1.f / DM); float s2 = 0.f;
#pragma unroll
        for (int j = 0; j < 8; ++j) { v[j] = v[j] - mean; s2 += (v[j].x * v[j].x + v[j].y * v[j].y) + (v[j].z * v[j].z + v[j].w * v[j].w); }
        const float rstd = 1.f / sqrtf(wave_sum_l(s2, lane) * (1.f / DM) + LN_EPS);
        GAS f32x4* o = (GAS f32x4*)(Xo + (size_t)m * DM) + lane;
#pragma unroll
        for (int j = 0; j < 8; ++j) { v[j] = v[j] * rstd * gv[j] + bv[j]; o[64 * j] = v[j]; }
        if (XBo) { GAS v2u* ob = (GAS v2u*)(XBo + (size_t)m * DM) + lane;
#pragma unroll
            for (int j = 0; j < 8; ++j) { v2u w; w.x = pk2(v[j].x, v[j].y); w.y = pk2(v[j].z, v[j].w); ob[64 * j] = w; } }
    }
}

__device__ __forceinline__ void conv_phase(const bf16* U, bf16* H, const float* cw  , const float* cb  , int gt, int NGT) {
    constexpr int RS = 16, NSTRIP = MTOK / RS, NCG = (UPN / 256) * 16;
    for (int it = gt; it < NSTRIP * NCG; it += NGT) {
        const int strip = it / NCG, cg = it % NCG, tile = cg >> 4, g8 = cg & 15;
        const int pc = tile * 256 + g8 * 8;
        const int t0 = strip * RS;
        float wg[3][8], wv[3][8], bg[8], bvv[8];
#pragma unroll
        for (int j = 0; j < 3; ++j) { const f32x4 a0 = *(const f32x4*)(cw + (size_t)j * UPN + pc), a1 = *(const f32x4*)(cw + (size_t)j * UPN + pc + 4), c0 = *(const f32x4*)(cw + (size_t)j * UPN + pc + 128), c1 = *(const f32x4*)(cw + (size_t)j * UPN + pc + 132);
#pragma unroll
            for (int e = 0; e < 4; ++e) { wg[j][e] = a0[e]; wg[j][4 + e] = a1[e]; wv[j][e] = c0[e]; wv[j][4 + e] = c1[e]; } }
        { const f32x4 a0 = *(const f32x4*)(cb + pc), a1 = *(const f32x4*)(cb + pc + 4), c0 = *(const f32x4*)(cb + pc + 128), c1 = *(const f32x4*)(cb + pc + 132);
#pragma unroll
          for (int e = 0; e < 4; ++e) { bg[e] = a0[e]; bg[4 + e] = a1[e]; bvv[e] = c0[e]; bvv[4 + e] = c1[e]; } }
        float g2[8], g1[8], v2[8], v1[8];
        const bool first = (t0 & (SEQ - 1)) == 0;
#pragma unroll
        for (int e = 0; e < 8; ++e) { g2[e] = 0.f; g1[e] = 0.f; v2[e] = 0.f; v1[e] = 0.f; }
        if (!first) {
            const v4u a = *(const v4u*)(U + (size_t)(t0 - 2) * UPN + pc), b = *(const v4u*)(U + (size_t)(t0 - 1) * UPN + pc), c = *(const v4u*)(U + (size_t)(t0 - 2) * UPN + pc + 128), d = *(const v4u*)(U + (size_t)(t0 - 1) * UPN + pc + 128);
#pragma unroll
            for (int e = 0; e < 4; ++e) { g2[2 * e] = bflo(a[e]); g2[2 * e + 1] = bfhi(a[e]); g1[2 * e] = bflo(b[e]); g1[2 * e + 1] = bfhi(b[e]);
                                          v2[2 * e] = bflo(c[e]); v2[2 * e + 1] = bfhi(c[e]); v1[2 * e] = bflo(d[e]); v1[2 * e + 1] = bfhi(d[e]); }
        }
#pragma unroll 4
        for (int r = 0; r < RS; ++r) {
            const int t = t0 + r;
            const v4u a = *(const v4u*)(U + (size_t)t * UPN + pc), c = *(const v4u*)(U + (size_t)t * UPN + pc + 128);
            float g0[8], v0[8], o[8];
#pragma unroll
            for (int e = 0; e < 4; ++e) { g0[2 * e] = bflo(a[e]); g0[2 * e + 1] = bfhi(a[e]); v0[2 * e] = bflo(c[e]); v0[2 * e + 1] = bfhi(c[e]); }
#pragma unroll
            for (int e = 0; e < 8; ++e) {
                const float cgt = bg[e] + wg[0][e] * g2[e] + wg[1][e] * g1[e] + wg[2][e] * g0[e];
                const float cvl = bvv[e] + wv[0][e] * v2[e] + wv[1][e] * v1[e] + wv[2][e] * v0[e];
                o[e] = cgt / (1.f + __expf(-cgt)) * cvl;
                g2[e] = g1[e]; g1[e] = g0[e]; v2[e] = v1[e]; v1[e] = v0[e];
            }
            v4u w; w.x = pk2(o[0], o[1]); w.y = pk2(o[2], o[3]); w.z = pk2(o[4], o[5]); w.w = pk2(o[6], o[7]);
            *(v4u*)(H + (size_t)t * DFF + tile * 128 + g8 * 8) = w;
        }
    }
}


namespace att {
constexpr float SCALE = 0.08838834764831845f, LOG2E = 1.4426950408889634f, C2 = LOG2E * SCALE, THR2 = 8.f * LOG2E;
constexpr int NW = 8, QBLK = 32, KVBLK = 64, QB = NW * QBLK, D = 128;
constexpr int SHM_V = KVBLK * D * 2, SHM_K = KVBLK * D * 2;
constexpr int WS_OFF = 2 * SHM_V + 2 * SHM_K, C2_OFF = WS_OFF + NW * 64 * 4, LDS_NEED = C2_OFF + SEQ * 4;
constexpr int KS = ATT_N, OS = DM;
typedef float f32x16 __attribute__((ext_vector_type(16)));
typedef unsigned u32x4 __attribute__((ext_vector_type(4)));

#define KSWZ(row, colB) ((row) * 256 + ((colB) ^ (((row) & 7) << 4)))
#define SBAR() __builtin_amdgcn_sched_barrier(0)
__device__ __forceinline__ int v_st(int k, int c) { const int kk = (k & ~0xC) | ((k & 4) << 1) | ((k & 8) >> 1); return ((kk >> 3) * 4 + (c >> 5)) * 512 + ((kk & 7) * 32 + (c & 31)) * 2; }
__device__ __forceinline__ int v_rd_base(int lane) { return ((lane & 3) << 3) | (((lane >> 2) & 3) << 6) | (((lane >> 4) & 1) << 5) | (((lane >> 5) & 1) << 8); }
constexpr int v_rd_off(int d0, int ks, int half) { return d0 * 512 + ks * 4096 + half * 2048; }
__device__ __forceinline__ int crow(int r, int hi) { return (r & 3) + 8 * (r >> 2) + 4 * hi; }
__device__ __forceinline__ unsigned cvtpk(float lo, float hi) { unsigned r; asm volatile("v_cvt_pk_bf16_f32 %0, %1, %2" : "=v"(r) : "v"(lo), "v"(hi)); return r; }
__device__ __forceinline__ bf16x8 load8(const bf16* p) { return *reinterpret_cast<const bf16x8*>(p); }
__device__ __forceinline__ void mask_tile(f32x16& p0, f32x16& p1, int dq, unsigned W) {
    const float NEG = -__builtin_inff();
#pragma unroll
    for (int r = 0; r < 16; ++r) {
        const int c = (r & 3) + 8 * (r >> 2);
        if ((unsigned)(dq - c) >= W) p0[r] = NEG;
        if ((unsigned)(dq - c - 32) >= W) p1[r] = NEG;
    }
}
template <int MODE>
__device__ __forceinline__ void partialSM(f32x16& p0, f32x16& p1, float& m_reg, float& mn, float& alpha, const LAS float* c2k  , float ct2) {
    if constexpr (MODE == 0) {
#pragma unroll
        for (int g = 0; g < 4; ++g) { const f32x4 b0 = *(const LAS f32x4*)(c2k + 8 * g), b1 = *(const LAS f32x4*)(c2k + 32 + 8 * g);
#pragma unroll
            for (int e = 0; e < 4; ++e) { p0[4 * g + e] = fmaf(p0[4 * g + e], C2, ct2 - b0[e]); p1[4 * g + e] = fmaf(p1[4 * g + e], C2, ct2 - b1[e]); } }
    } else {
#pragma unroll
        for (int r = 0; r < 16; ++r) { p0[r] *= C2; p1[r] *= C2; }
    }
    float pmax = p0[0];
#pragma unroll
    for (int r = 1; r < 16; ++r) pmax = fmaxf(pmax, p0[r]);
#pragma unroll
    for (int r = 0; r < 16; ++r) pmax = fmaxf(pmax, p1[r]);
    { auto rr = __builtin_amdgcn_permlane32_swap(__float_as_uint(pmax), __float_as_uint(pmax), false, false);
      pmax = fmaxf(__uint_as_float(rr[0]), __uint_as_float(rr[1])); }
    if (__builtin_expect(__all((pmax - m_reg) <= THR2), 1)) { mn = m_reg; alpha = 1.f; }
    else { mn = fmaxf(m_reg, pmax); alpha = __builtin_amdgcn_exp2f(m_reg - mn); m_reg = mn; }
#pragma unroll
    for (int r = 0; r < 16; ++r) { p0[r] -= mn; p1[r] -= mn; }
#pragma unroll
    for (int r = 0; r < 16; ++r) p0[r] = __builtin_amdgcn_exp2f(p0[r]);
}
__device__ __forceinline__ void finishSM(f32x16& p0, f32x16& p1, float alpha, float& l_reg, bf16x8& pa0, bf16x8& pa1, bf16x8& pa2, bf16x8& pa3) {
#pragma unroll
    for (int r = 0; r < 16; ++r) p1[r] = __builtin_amdgcn_exp2f(p1[r]);
    float ps = 0;
#pragma unroll
    for (int r = 0; r < 16; ++r) ps += p0[r];
#pragma unroll
    for (int r = 0; r < 16; ++r) ps += p1[r];
    { auto rr = __builtin_amdgcn_permlane32_swap(__float_as_uint(ps), __float_as_uint(ps), false, false);
      ps = __uint_as_float(rr[0]) + __uint_as_float(rr[1]); }
    l_reg = l_reg * alpha + ps;
#define PK4(P, B_, OUT) do { unsigned a0 = cvtpk(P[B_+0], P[B_+1]), a1 = cvtpk(P[B_+2], P[B_+3]);                          \
        unsigned b0 = cvtpk(P[B_+4], P[B_+5]), b1 = cvtpk(P[B_+6], P[B_+7]);                                             \
        auto r0 = __builtin_amdgcn_permlane32_swap(a0, b0, false, false); auto r1 = __builtin_amdgcn_permlane32_swap(a1, b1, false, false); \
        u32x4 w = {r0[0], r1[0], r0[1], r1[1]}; OUT = *reinterpret_cast<bf16x8*>(&w); } while (0)
    PK4(p0, 0, pa0); PK4(p0, 8, pa1); PK4(p1, 0, pa2); PK4(p1, 8, pa3);
#undef PK4
}
template <int KB, bool SK>
__device__ __forceinline__ void qkt(f32x16& p0, f32x16& p1, const char* K_lds, int r32, int hi, const bf16x8* qr, bool act) {
    if (SK && !act) { const float NEG = -__builtin_inff();
#pragma unroll
        for (int r = 0; r < 16; ++r) { p0[r] = NEG; p1[r] = NEG; } return; }
    p0 = f32x16{}; p1 = f32x16{};
    const char* kb[4];
#pragma unroll
    for (int dd = 0; dd < 4; ++dd) kb[dd] = K_lds + KB * SHM_K + KSWZ(r32, (dd * 16 + hi * 8) * 2);
#pragma unroll
    for (int d0 = 0; d0 < 8; ++d0) { const char* a = kb[d0 & 3] + (d0 >> 2) * 128;
        bf16x8 b0 = *reinterpret_cast<const bf16x8*>(a);
        bf16x8 b1 = *reinterpret_cast<const bf16x8*>(a + 32 * 256);
        p0 = __builtin_amdgcn_mfma_f32_32x32x16_bf16(b0, qr[d0], p0, 0, 0, 0);
        p1 = __builtin_amdgcn_mfma_f32_32x32x16_bf16(b1, qr[d0], p1, 0, 0, 0); }
}
template <int VB, bool SK>
__device__ __forceinline__ void pv_tile(f32x16* o, int vb0, bf16x8 pa0, bf16x8 pa1, bf16x8 pa2, bf16x8 pa3, bool act) {
    if (SK && !act) return;
#define TRRD(dst, off) asm volatile("ds_read_b64_tr_b16 %0, %1 offset:%2" : "=&v"(dst) : "v"(vb0), "i"(off) : "memory")
#define PV_D0(d0) do { s16x4 l0, l1, l2, l3, h0, h1, h2, h3; constexpr int b_ = VB * SHM_V + v_rd_off(d0, 0, 0); \
        TRRD(l0, b_); TRRD(h0, b_ + 2048); TRRD(l1, b_ + 4096); TRRD(h1, b_ + 6144); TRRD(l2, b_ + 8192); TRRD(h2, b_ + 10240); TRRD(l3, b_ + 12288); TRRD(h3, b_ + 14336); \
        asm volatile("s_waitcnt lgkmcnt(0)" ::: "memory"); SBAR();   \
        o[d0] = __builtin_amdgcn_mfma_f32_32x32x16_bf16(pa0, (bf16x8){l0[0], l0[1], l0[2], l0[3], h0[0], h0[1], h0[2], h0[3]}, o[d0], 0, 0, 0);   \
        o[d0] = __builtin_amdgcn_mfma_f32_32x32x16_bf16(pa1, (bf16x8){l1[0], l1[1], l1[2], l1[3], h1[0], h1[1], h1[2], h1[3]}, o[d0], 0, 0, 0);   \
        o[d0] = __builtin_amdgcn_mfma_f32_32x32x16_bf16(pa2, (bf16x8){l2[0], l2[1], l2[2], l2[3], h2[0], h2[1], h2[2], h2[3]}, o[d0], 0, 0, 0);   \
        o[d0] = __builtin_amdgcn_mfma_f32_32x32x16_bf16(pa3, (bf16x8){l3[0], l3[1], l3[2], l3[3], h3[0], h3[1], h3[2], h3[3]}, o[d0], 0, 0, 0); } while (0)
    PV_D0(0); PV_D0(1); PV_D0(2); PV_D0(3);
#undef PV_D0
#undef TRRD
}

struct BlockRef { const bf16* Q; const bf16* K; const bf16* V; bf16* O; int P0; float m0; };
struct Seam { bf16x8 qr[8]; bf16x8 st_v0, st_v1, st_k0, st_k1; };
__device__ __forceinline__ int swa_jlo(int P0, int W) { const int lowk = P0 - W + 1; return lowk > 0 ? lowk / KVBLK : 0; }
#define ROW(p, k0, rr) ((p) + (size_t)((k0) + (rr)) * KS + sc)
#define VMW() asm volatile("s_waitcnt vmcnt(0)" ::: "memory")
#define VMWN(n) asm volatile("s_waitcnt vmcnt(%0)" :: "i"(n) : "memory")
#define SLOAD_H(Kp, Vp, k0) do { S.st_v0 = load8(ROW(Vp, k0, sr)); S.st_v1 = load8(ROW(Vp, k0, 32 + sr));              \
                         S.st_k0 = load8(ROW(Kp, k0, sr)); S.st_k1 = load8(ROW(Kp, k0, 32 + sr)); } while (0)
#define SWRITE_HK(bf) do { *(bf16x8*)(K_lds + (bf) * SHM_K + kws) = S.st_k0; *(bf16x8*)(K_lds + (bf) * SHM_K + kws + 32 * 256) = S.st_k1; } while (0)
#define SWRITE_HV(bf) do { *(bf16x8*)(V_lds + (bf) * SHM_V + vst0) = S.st_v0; *(bf16x8*)(V_lds + (bf) * SHM_V + vst1) = S.st_v1; } while (0)
#define SWRITE_H(bf) do { SWRITE_HV(bf); SWRITE_HK(bf); } while (0)
template <int W>
__device__ __forceinline__ void prime(const BlockRef& cur, char* lds, Seam& S) {
    int tid_l = threadIdx.x; asm volatile("" : "+v"(tid_l));
    const int tid = tid_l, wid = __builtin_amdgcn_readfirstlane(tid >> 6), lane = tid & 63, r32 = lane & 31, hi = lane >> 5;
    const int sr = tid >> 4, sc = (tid & 15) * 8, kws = KSWZ(sr, sc * 2); char* K_lds = lds + 2 * SHM_V;
    const int kb0 = swa_jlo(cur.P0, W) * KVBLK;
#pragma unroll
    for (int d0 = 0; d0 < 8; ++d0) S.qr[d0] = load8(cur.Q + (size_t)(wid * QBLK + r32) * KS + d0 * 16 + hi * 8);
    SLOAD_H(cur.K, cur.V, kb0); VMW(); SWRITE_HK(0);
    __syncthreads();
}
template <int MODE, int W, bool SK>
__device__ __forceinline__ void block(const BlockRef& cur, const BlockRef& nxt, char* lds, Seam& S) {
    int tid_l = threadIdx.x; asm volatile("" : "+v"(tid_l));
    const int tid = tid_l, wid = __builtin_amdgcn_readfirstlane(tid >> 6), lane = tid & 63, r32 = lane & 31, hi = lane >> 5;
    const int j_lo = swa_jlo(cur.P0, W);
    const int j_hi = (cur.P0 + QB - 1) / KVBLK + 1;
    const int NT = j_hi - j_lo;
    const int kbn = swa_jlo(nxt.P0, W) * KVBLK;
    const int qlo = cur.P0 + wid * QBLK, qm = qlo + r32 - 4 * hi;
    char* V_lds = lds; char* K_lds = lds + 2 * SHM_V;
    float* ws = (float*)(lds + WS_OFF) + wid * 64; float* li_l = ws, * al_l = ws + 32;
    const LAS float* c2 = (const LAS float*)((LAS unsigned char*)lds + C2_OFF);
    const float ct2 = (MODE == 0) ? c2[qlo + r32] : 0.f;
    float m_reg = (MODE == 0) ? -1e30f : cur.m0, l_reg = (MODE == 0) ? 0.f : 1.f; f32x16 o[4] = {};
    const int sr = tid >> 4, sc = (tid & 15) * 8, vst0 = v_st(sr, sc), vst1 = v_st(32 + sr, sc), kws = KSWZ(sr, sc * 2);
    const int vb0 = (int)(uintptr_t)V_lds + v_rd_base(lane);
    const bf16* Kh = cur.K; const bf16* Vh = cur.V;
#define RESC(a) do { if (__any((a) < 1.f)) { if (hi == 0) al_l[r32] = (a); asm volatile("s_waitcnt lgkmcnt(0)" ::: "memory");              \
                     for (int d_ = 0; d_ < 4; ++d_) for (int r = 0; r < 16; ++r) o[d_][r] *= al_l[crow(r, hi)]; } } while (0)
#define KBASE(t) ((j_lo + (t)) * KVBLK)
#define ACT(t) (KBASE(t) <= qlo + QBLK - 1 && KBASE(t) + KVBLK - 1 >= qlo - W + 1)
#define MASKT(P0_, P1_, t) do { const int kb_ = KBASE(t); if ((!SK || ACT(t)) && (kb_ + KVBLK - 1 > qlo || kb_ <= qlo + QBLK - 1 - W)) mask_tile(P0_, P1_, qm - kb_, (unsigned)W); } while (0)
#define PSM(PX0, PX1, mnX, alX, t) partialSM<MODE>(PX0, PX1, m_reg, mnX, alX, c2 + KBASE(t) + 4 * hi, ct2)
    constexpr int NQL = 8;
#define SEAM_K0() do { VMWN(NQL); SWRITE_HK(0); SBAR(); } while (0)
    f32x16 pA0, pA1, pB0, pB1; float mnA, mnB, alA, alB; bf16x8 pa0, pa1, pa2, pa3;
    SWRITE_HV(0); SBAR();
    if (NT > 1) { SLOAD_H(Kh, Vh, KBASE(1)); }
    SBAR(); qkt<0, SK>(pA0, pA1, K_lds, r32, hi, S.qr, ACT(0));
    MASKT(pA0, pA1, 0); PSM(pA0, pA1, mnA, alA, 0);
    if (NT > 1) { VMW(); SWRITE_H(1); }
    __syncthreads();
#define HALF_STEP(PX0, PX1, mnX, alX, PY0, PY1, alY, t, KB, VB, SB) do {                                                      \
        SBAR(); qkt<KB, SK>(PX0, PX1, K_lds, r32, hi, S.qr, ACT(t));                                             \
        finishSM(PY0, PY1, alY, l_reg, pa0, pa1, pa2, pa3); SBAR();                                                           \
        if ((t) + 1 < NT) { SLOAD_H(Kh, Vh, KBASE((t) + 1)); SBAR(); }                                               \
        pv_tile<VB, SK>(o, vb0, pa0, pa1, pa2, pa3, ACT((t) - 1)); MASKT(PX0, PX1, (t)); PSM(PX0, PX1, mnX, alX, (t));                                        \
        __syncthreads();                                                                                                      \
        if ((t) + 1 < NT) { VMW(); SWRITE_H(SB); }                                                                          \
        RESC(alX); __syncthreads(); } while (0)
    for (int t = 1; t + 1 < NT; t += 2) {
        HALF_STEP(pB0, pB1, mnB, alB, pA0, pA1, alA, t, 1, 0, 0);
        HALF_STEP(pA0, pA1, mnA, alA, pB0, pB1, alB, t + 1, 0, 1, 1);
    }
    const bool even = (NT & 1) == 0;
    if (even) { SBAR(); qkt<1, SK>(pB0, pB1, K_lds, r32, hi, S.qr, ACT(NT - 1)); SBAR(); }
    SLOAD_H(nxt.K, nxt.V, kbn); SBAR();
#pragma unroll
    for (int d0 = 0; d0 < 8; ++d0) S.qr[d0] = load8(nxt.Q + (size_t)(wid * QBLK + r32) * KS + d0 * 16 + hi * 8);
    SBAR();
    finishSM(pA0, pA1, alA, l_reg, pa0, pa1, pa2, pa3); SBAR();
    pv_tile<0, SK>(o, vb0, pa0, pa1, pa2, pa3, ACT(even ? NT - 2 : NT - 1));
    if (even) { MASKT(pB0, pB1, NT - 1); PSM(pB0, pB1, mnB, alB, NT - 1); __syncthreads(); RESC(alB);
        finishSM(pB0, pB1, alB, l_reg, pa0, pa1, pa2, pa3); SBAR(); pv_tile<1, SK>(o, vb0, pa0, pa1, pa2, pa3, ACT(NT - 1)); }
    SBAR(); SEAM_K0();
    if (hi == 0) li_l[r32] = l_reg; asm volatile("s_waitcnt lgkmcnt(0)" ::: "memory");
    float rli[16];
#pragma unroll
    for (int r = 0; r < 16; ++r) rli[r] = __builtin_amdgcn_rcpf(li_l[crow(r, hi)]);
    bf16* Ow = cur.O + (size_t)(wid * QBLK) * OS;
#pragma unroll
    for (int r = 0; r < 16; ++r) { const int orow = crow(r, hi);
#pragma unroll
        for (int d0 = 0; d0 < 4; ++d0) { const float v = o[d0][r] * rli[r];
            const float vn = shfl_idx(v, lane ^ 1);
            if ((r32 & 1) == 0) *(unsigned*)(Ow + (size_t)orow * OS + d0 * 32 + r32) = cvtpk(v, vn); } }
    __syncthreads();
#undef RESC
#undef KBASE
#undef ACT
#undef MASKT
#undef PSM
#undef SEAM_K0
#undef HALF_STEP
}
#undef ROW
#undef VMW
#undef VMWN
#undef SLOAD_H
#undef SWRITE_HK
#undef SWRITE_HV
#undef SWRITE_H

__device__ __forceinline__ void fox_ctable(const float* GATES, int b, int h, char* lds) {
    LAS float* c2 = (LAS float*)((LAS unsigned char*)lds + C2_OFF);
    LAS float* wsum = (LAS float*)((LAS unsigned char*)lds + WS_OFF);
    int tid_l = threadIdx.x; asm volatile("" : "+v"(tid_l));
    const int tid = tid_l, lane = tid & 63, wid = tid >> 6;
    float v[8]; float s = 0.f;
#pragma unroll
    for (int e = 0; e < 8; ++e) { v[e] = log_sigmoid(GATES[(size_t)(b * SEQ + tid * 8 + e) * 16 + h]) * LOG2E; s += v[e]; v[e] = s; }
    float inc = s;
#pragma unroll
    for (int o = 1; o < 64; o <<= 1) { const float t = shfl_idx(inc, lane - o); if (lane >= o) inc += t; }
    if (lane == 63) wsum[wid] = inc;
    __syncthreads();
    float base = inc - s;
    for (int w = 0; w < wid; ++w) base += wsum[w];
#pragma unroll
    for (int e = 0; e < 8; ++e) c2[tid * 8 + e] = base + v[e];
    __syncthreads();
}

__device__ __forceinline__ void attn_phase(const bf16* PROJ, const float* GATES, const float* sinks, bf16* HEADS, char* lds, int bx, int G) {
    constexpr int NQB = SEQ / QB;
    for (int L = bx; L < NBATCH * FOXH * (NQB / 2); L += G) {
        const int bh = L / (NQB / 2), x = L % (NQB / 2), b = bh / FOXH, h = bh % FOXH;
        fox_ctable(GATES, b, h, lds);
        const bf16* base = PROJ + (size_t)b * SEQ * KS;
        BlockRef r0, r1;
        r0.Q = base + (size_t)(x * QB) * KS + A_FQ + h * 128; r0.K = base + A_FK + h * 128; r0.V = base + A_FV + h * 128; r0.O = HEADS + ((size_t)b * SEQ + x * QB) * OS + h * 128; r0.P0 = x * QB; r0.m0 = 0.f;
        const int y = NQB - 1 - x;
        r1 = r0; r1.Q = base + (size_t)(y * QB) * KS + A_FQ + h * 128; r1.O = HEADS + ((size_t)b * SEQ + y * QB) * OS + h * 128; r1.P0 = y * QB;
        Seam S;
        prime<SEQ>(r0, lds, S);
        BlockRef cur = r0, nxt = r1;
        for (int pass = 0; pass < 2; ++pass) { block<0, SEQ, false>(cur, nxt, lds, S); cur = nxt; }
    }
    for (int L = bx; L < NBATCH * SWAQ * (NQB / 2); L += G) {
        const int bh = L / (NQB / 2), x = L % (NQB / 2), b = bh / SWAQ, h = bh % SWAQ, kvh = h / (SWAQ / SWAKV);
        const bf16* base = PROJ + (size_t)b * SEQ * KS;
        BlockRef r0, r1;
        r0.Q = base + (size_t)(2 * x * QB) * KS + A_SQ + h * 128; r0.K = base + A_SK + kvh * 128; r0.V = base + A_SV + kvh * 128; r0.O = HEADS + ((size_t)b * SEQ + 2 * x * QB) * OS + 1024 + h * 128; r0.P0 = 2 * x * QB;
        r0.m0 = sinks[h] * LOG2E;
        r1 = r0; r1.Q = r0.Q + (size_t)QB * KS; r1.O = r0.O + (size_t)QB * OS; r1.P0 = r0.P0 + QB;
        Seam S;
        prime<SWAW>(r0, lds, S);
        BlockRef cur = r0, nxt = r1;
        for (int pass = 0; pass < 2; ++pass) { block<1, SWAW, true>(cur, nxt, lds, S); cur = nxt; }
    }
}
#undef KSWZ
#undef SBAR
}

namespace mls {
constexpr float SCALE = 0.08838834764831845f, LOG2E = 1.4426950408889634f;
constexpr int RS = 272, RSV = 144;
constexpr int QT = 0, KT = 17408, VT = 34816, VW = 44032, CB = 53248;
constexpr int A2O = 71680, M2O = A2O + 16384, NBO = M2O + 16384, MCO = NBO + 16384, BLO = MCO + 256, AMO = BLO + 256, LDS_NEED = AMO + 256;
static_assert(LDS_NEED <= 131072, "mlstm LDS");
typedef float f32x16 __attribute__((ext_vector_type(16)));
typedef unsigned u32x4 __attribute__((ext_vector_type(4)));
__device__ __forceinline__ unsigned cvtpk(float lo, float hi) { unsigned r; asm volatile("v_cvt_pk_bf16_f32 %0, %1, %2" : "=v"(r) : "v"(lo), "v"(hi)); return r; }
__device__ __forceinline__ int crow(int r, int hi) { return (r & 3) + 8 * (r >> 2) + 4 * hi; }
#define MLS_TR(dst, addr, off) asm volatile("ds_read_b64_tr_b16 %0, %1 offset:%2" : "=&v"(dst) : "v"(addr), "i"(off) : "memory")
#define MLS_PK4(P, B_, OUT) do { unsigned a0 = cvtpk(P[B_+0], P[B_+1]), a1 = cvtpk(P[B_+2], P[B_+3]);                          \
        unsigned b0 = cvtpk(P[B_+4], P[B_+5]), b1 = cvtpk(P[B_+6], P[B_+7]);                                             \
        auto r0 = __builtin_amdgcn_permlane32_swap(a0, b0, false, false); auto r1 = __builtin_amdgcn_permlane32_swap(a1, b1, false, false); \
        u32x4 w = {r0[0], r1[0], r0[1], r1[1]}; OUT = *reinterpret_cast<bf16x8*>(&w); } while (0)

__device__ __forceinline__ void mlstm_unit(const bf16* PROJ, const float* GATES, bf16* HEADS, LAS unsigned char* lds, int b, int h, int vs) {
    int tid_l = threadIdx.x; asm volatile("" : "+v"(tid_l));
    const int tid = tid_l, lane = tid & 63, wid = __builtin_amdgcn_readfirstlane(tid >> 6), r = lane & 31, hh = lane >> 5;
    LAS float* A2 = (LAS float*)(lds + A2O); LAS float* M2 = (LAS float*)(lds + M2O); LAS float* NB = (LAS float*)(lds + NBO);
    LAS float* MC = (LAS float*)(lds + MCO); LAS float* BL = (LAS float*)(lds + BLO); LAS float* AM = (LAS float*)(lds + AMO);
    const float NEG = -__builtin_inff();
    unsigned zl = 0u; asm volatile("" : "+v"(zl));
    for (int i = tid; i < (CB + 64 * RS - VT) / 16; i += NTHREADS) *(LAS v4u*)(lds + VT + i * 16) = (v4u){zl, zl, zl, zl};
    {
        float ip[8], lf[8];
#pragma unroll
        for (int e = 0; e < 8; ++e) { const size_t row = (size_t)(b * SEQ + tid * 8 + e); ip[e] = GATES[row * 16 + h]; lf[e] = log_sigmoid(GATES[row * 16 + 8 + h]); }
        float run = 0.f;
#pragma unroll
        for (int e = 0; e < 8; ++e) { run += lf[e]; lf[e] = run; }
        float inc = run;
#pragma unroll
        for (int o = 1; o < 8; o <<= 1) { const float t = shfl_idx(inc, lane - o); if ((lane & 7) >= o) inc += t; }
        const float base = inc - run;
        float bb[8], cm[8]; float rm = NEG;
#pragma unroll
        for (int e = 0; e < 8; ++e) { bb[e] = base + lf[e]; const float aa = ip[e] - bb[e]; A2[tid * 8 + e] = aa * LOG2E; rm = fmaxf(rm, aa); cm[e] = rm; }
        float incm = rm;
#pragma unroll
        for (int o = 1; o < 8; o <<= 1) { const float t = shfl_idx(incm, lane - o); if ((lane & 7) >= o) incm = fmaxf(incm, t); }
        float ex = shfl_idx(incm, lane - 1); if ((lane & 7) == 0) ex = NEG;
#pragma unroll
        for (int e = 0; e < 8; ++e) cm[e] = fmaxf(cm[e], ex);
        if ((tid & 7) == 7) { BL[tid >> 3] = bb[7]; AM[tid >> 3] = cm[7]; }
        __syncthreads();
        if (tid < 64) *(LAS unsigned short*)(lds + VT + tid * RSV + 64) = (unsigned short)0x3F80;
        if (tid == 0) { float m = 0.f; for (int c = 0; c < SEQ / MLCH; ++c) { MC[c] = m; m = BL[c] + fmaxf(m, AM[c]); } }
        __syncthreads();
        const float mc = MC[tid >> 3];
#pragma unroll
        for (int e = 0; e < 8; ++e) { const float M = fmaxf(mc, cm[e]); M2[tid * 8 + e] = M * LOG2E; NB[tid * 8 + e] = __builtin_amdgcn_exp2f(-(bb[e] + M) * LOG2E); }
        __syncthreads();
        if (tid < 64) MC[tid] *= LOG2E;
        __syncthreads();
    }
    const bf16* pbase = PROJ + (size_t)b * SEQ * ML_N;
    const int qcol = L_Q + h * 128, kcol = L_K + h * 128, vcol = L_V + h * 256 + vs * 32, ocol = L_O + h * 256 + vs * 32;
    v4u rq[2], rk[2], rv = (v4u){zl, zl, zl, zl};
#define MLS_LOAD(c) do { const bf16* rb = pbase + (size_t)((c) * MLCH) * ML_N;                                                          \
        _Pragma("unroll") for (int i = 0; i < 2; ++i) { const int id = tid + NTHREADS * i, row = id >> 4, ch = id & 15;               \
            rq[i] = *(const v4u*)(rb + (size_t)row * ML_N + qcol + ch * 8); rk[i] = *(const v4u*)(rb + (size_t)row * ML_N + kcol + ch * 8); } \
        if (tid < 256) rv = *(const v4u*)(rb + (size_t)(tid >> 2) * ML_N + vcol + (tid & 3) * 8); } while (0)
    MLS_LOAD(0);
    f32x16 CA0 = {}, CA1 = {};
    const unsigned ldsb = (unsigned)(uintptr_t)lds;
    const int blk = (lane >> 4) & 1, q4 = (lane & 15) >> 2, p4 = lane & 3;
    for (int c = 0; c < SEQ / MLCH; ++c) {
        const int cb = c * MLCH;
        {
#pragma unroll
            for (int i = 0; i < 2; ++i) { const int id = tid + NTHREADS * i, row = id >> 4, ch = id & 15;
                *(LAS v4u*)(lds + QT + row * RS + ch * 16) = rq[i]; *(LAS v4u*)(lds + KT + row * RS + ch * 16) = rk[i]; }
            const float m63 = M2[cb + 63];
            if (tid < 256) { const int row = tid >> 2, ch = tid & 3; *(LAS v4u*)(lds + VT + row * RSV + ch * 16) = rv;
                const float w = __builtin_amdgcn_exp2f(A2[cb + row] - m63) * SCALE; v4u o;
#pragma unroll
                for (int e = 0; e < 4; ++e) o[e] = pk2(bflo(rv[e]) * w, bfhi(rv[e]) * w);
                *(LAS v4u*)(lds + VW + row * RSV + ch * 16) = o; }
            else if (tid < 320) { const int row = tid - 256; const float w = __builtin_amdgcn_exp2f(A2[cb + row] - m63) * SCALE;
                *(LAS v4u*)(lds + VW + row * RSV + 64) = (v4u){f2bf(w), zl, zl, zl}; }
        }
        __syncthreads();
        if (c + 1 < SEQ / MLCH) MLS_LOAD(c + 1);
        if (wid < 2) {
            const int tb = wid;
            const size_t grow0 = (size_t)(b * SEQ + cb + 32 * tb);
            unsigned short og[16];
#pragma unroll
            for (int rr = 0; rr < 16; ++rr) og[rr] = pbase[(size_t)(cb + 32 * tb + crow(rr, hh)) * ML_N + ocol + r];
            bf16x8 qf[8];
#pragma unroll
            for (int s = 0; s < 8; ++s) qf[s] = *(const LAS bf16x8*)(lds + QT + (32 * tb + r) * RS + (16 * s + 8 * hh) * 2);
            f32x16 acc0 = {}, acc1 = {};
#pragma unroll
            for (int s = 0; s < 8; ++s) { const bf16x8 c0 = *(const LAS bf16x8*)(lds + CB + r * RS + (16 * s + 8 * hh) * 2), c1 = *(const LAS bf16x8*)(lds + CB + (32 + r) * RS + (16 * s + 8 * hh) * 2);
                acc0 = __builtin_amdgcn_mfma_f32_32x32x16_bf16(qf[s], c0, acc0, 0, 0, 0); acc1 = __builtin_amdgcn_mfma_f32_32x32x16_bf16(qf[s], c1, acc1, 0, 0, 0); }
            const float mc2 = MC[c];
#pragma unroll
            for (int g = 0; g < 4; ++g) { const f32x4 m4 = *(const LAS f32x4*)(M2 + cb + 32 * tb + 8 * g + 4 * hh);
#pragma unroll
                for (int e = 0; e < 4; ++e) { const float it = __builtin_amdgcn_exp2f(mc2 - m4[e]); acc0[4 * g + e] *= it; acc1[4 * g + e] *= it; } }
            const float m2t = M2[cb + 32 * tb + r];
            const unsigned vbase = ldsb + VT + (8 * hh + q4) * RSV + (16 * blk + 4 * p4) * 2;
#pragma unroll
            for (int sb = 0; sb < 2; ++sb) {
                if (sb <= tb) {
                    f32x16 p = {};
#pragma unroll
                    for (int s = 0; s < 8; ++s) { const bf16x8 kf = *(const LAS bf16x8*)(lds + KT + (32 * sb + r) * RS + (16 * s + 8 * hh) * 2); p = __builtin_amdgcn_mfma_f32_32x32x16_bf16(kf, qf[s], p, 0, 0, 0); }
#pragma unroll
                    for (int g = 0; g < 4; ++g) { const f32x4 a4 = *(const LAS f32x4*)(A2 + cb + 32 * sb + 8 * g + 4 * hh);
#pragma unroll
                        for (int e = 0; e < 4; ++e) { const float w = __builtin_amdgcn_exp2f(a4[e] - m2t) * SCALE; float val = p[4 * g + e] * w;
                            if (sb == tb && (8 * g + 4 * hh + e) > r) val = 0.f;
                            p[4 * g + e] = val; } }
                    bf16x8 pa0, pa1; MLS_PK4(p, 0, pa0); MLS_PK4(p, 8, pa1);
                    s16x4 l0, h0, l1, h1, l2, h2, l3, h3;
                    if (sb == 0) { MLS_TR(l0, vbase, 0); MLS_TR(h0, vbase, 4 * RSV); MLS_TR(l1, vbase, 64); MLS_TR(h1, vbase, 64 + 4 * RSV);
                                   MLS_TR(l2, vbase, 16 * RSV); MLS_TR(h2, vbase, 20 * RSV); MLS_TR(l3, vbase, 16 * RSV + 64); MLS_TR(h3, vbase, 20 * RSV + 64); }
                    else         { MLS_TR(l0, vbase, 32 * RSV); MLS_TR(h0, vbase, 36 * RSV); MLS_TR(l1, vbase, 32 * RSV + 64); MLS_TR(h1, vbase, 36 * RSV + 64);
                                   MLS_TR(l2, vbase, 48 * RSV); MLS_TR(h2, vbase, 52 * RSV); MLS_TR(l3, vbase, 48 * RSV + 64); MLS_TR(h3, vbase, 52 * RSV + 64); }
                    asm volatile("s_waitcnt lgkmcnt(0)" ::: "memory"); __builtin_amdgcn_sched_barrier(0);
                    acc0 = __builtin_amdgcn_mfma_f32_32x32x16_bf16(pa0, (bf16x8){l0[0], l0[1], l0[2], l0[3], h0[0], h0[1], h0[2], h0[3]}, acc0, 0, 0, 0);
                    acc1 = __builtin_amdgcn_mfma_f32_32x32x16_bf16(pa0, (bf16x8){l1[0], l1[1], l1[2], l1[3], h1[0], h1[1], h1[2], h1[3]}, acc1, 0, 0, 0);
                    acc0 = __builtin_amdgcn_mfma_f32_32x32x16_bf16(pa1, (bf16x8){l2[0], l2[1], l2[2], l2[3], h2[0], h2[1], h2[2], h2[3]}, acc0, 0, 0, 0);
                    acc1 = __builtin_amdgcn_mfma_f32_32x32x16_bf16(pa1, (bf16x8){l3[0], l3[1], l3[2], l3[3], h3[0], h3[1], h3[2], h3[3]}, acc1, 0, 0, 0);
                }
            }
#pragma unroll
            for (int g = 0; g < 4; ++g) { const f32x4 nb4 = *(const LAS f32x4*)(NB + cb + 32 * tb + 8 * g + 4 * hh);
#pragma unroll
                for (int e = 0; e < 4; ++e) { const int rr = 4 * g + e; const float dot = shfl_idx(acc1[rr], lane & 32);
                    const float den = fmaxf(fabsf(dot), nb4[e]); const float hv = acc0[rr] / den; const float o = bf2f(og[rr]);
                    HEADS[(grow0 + crow(rr, hh)) * DM + h * 256 + vs * 32 + r] = (bf16)f2bf(hv / (1.f + __expf(-o))); } }
        } else if (wid >= 4) {
            const int u = wid - 4;
            const float decay = __builtin_amdgcn_exp2f(MC[c] - M2[cb + 63]);
#pragma unroll
            for (int rr = 0; rr < 16; ++rr) { CA0[rr] *= decay; CA1[rr] *= decay; }
            const unsigned kbase = ldsb + KT + (8 * hh + q4) * RS + (32 * u + 16 * blk + 4 * p4) * 2;
            const unsigned wbase = ldsb + VW + (8 * hh + q4) * RSV + (16 * blk + 4 * p4) * 2;
#define MLS_UPD(ks) do { s16x4 al, ah, b0l, b0h, b1l, b1h;                                                                        \
                MLS_TR(al, kbase, (ks) * 16 * RS); MLS_TR(ah, kbase, (ks) * 16 * RS + 4 * RS);                                       \
                MLS_TR(b0l, wbase, (ks) * 16 * RSV); MLS_TR(b0h, wbase, (ks) * 16 * RSV + 4 * RSV);                                  \
                MLS_TR(b1l, wbase, (ks) * 16 * RSV + 64); MLS_TR(b1h, wbase, (ks) * 16 * RSV + 4 * RSV + 64);                        \
                asm volatile("s_waitcnt lgkmcnt(0)" ::: "memory"); __builtin_amdgcn_sched_barrier(0);                              \
                const bf16x8 af = (bf16x8){al[0], al[1], al[2], al[3], ah[0], ah[1], ah[2], ah[3]};                                   \
                CA0 = __builtin_amdgcn_mfma_f32_32x32x16_bf16(af, (bf16x8){b0l[0], b0l[1], b0l[2], b0l[3], b0h[0], b0h[1], b0h[2], b0h[3]}, CA0, 0, 0, 0); \
                CA1 = __builtin_amdgcn_mfma_f32_32x32x16_bf16(af, (bf16x8){b1l[0], b1l[1], b1l[2], b1l[3], b1h[0], b1h[1], b1h[2], b1h[3]}, CA1, 0, 0, 0); } while (0)
            MLS_UPD(0); MLS_UPD(1); MLS_UPD(2); MLS_UPD(3);
#undef MLS_UPD
        }
        __syncthreads();
        if (wid >= 4) {
            const int u = wid - 4;
#pragma unroll
            for (int g = 0; g < 4; ++g) {
                v2u w0, w1; w0.x = cvtpk(CA0[4 * g], CA0[4 * g + 1]); w0.y = cvtpk(CA0[4 * g + 2], CA0[4 * g + 3]); w1.x = cvtpk(CA1[4 * g], CA1[4 * g + 1]); w1.y = cvtpk(CA1[4 * g + 2], CA1[4 * g + 3]);
                *(LAS v2u*)(lds + CB + r * RS + (32 * u + 8 * g + 4 * hh) * 2) = w0;
                *(LAS v2u*)(lds + CB + (32 + r) * RS + (32 * u + 8 * g + 4 * hh) * 2) = w1; }
        }
    }
    __syncthreads();
#undef MLS_LOAD
}
__device__ __forceinline__ void mlstm_phase(const bf16* PROJ, const float* GATES, bf16* HEADS, LAS unsigned char* lds, int bx, int G) {
    for (int L = bx; L < NBATCH * MLH * 8; L += G) { const int bh = L >> 3, vs = L & 7; mlstm_unit(PROJ, GATES, HEADS, lds, bh / MLH, bh % MLH, vs); }
}
#undef MLS_TR
#undef MLS_PK4
}
#define MLSTM_PHASE mls::mlstm_phase(PROJ, GATES, HEADS, lds, bx, G);
#ifndef MLSTM_PHASE
#define MLSTM_PHASE ;
#endif

__global__ void __launch_bounds__(NTHREADS, 2) mega(Args a) {
    extern __shared__ __attribute__((aligned(16))) unsigned char lds_raw[];
    LAS unsigned char* lds = (LAS unsigned char*)lds_raw;
    const int tid = threadIdx.x, lane = tid & 63, wave = __builtin_amdgcn_readfirstlane(tid >> 6);
    const int G = gridDim.x, bx = blockIdx.x;
    const int vcu = (G % 8 == 0) ? (bx % 8) * (G / 8) + bx / 8 : bx;
    for (int u = tid; u < (LDS_BYTES - LDSCTL_OFF) / 4; u += NTHREADS) ((LAS unsigned*)(lds + LDSCTL_OFF))[u] = 0u;
    __syncthreads();
    unsigned char* ws = a.ws;
    gu32* ctl = (gu32*)(ws + WS_CTL);
    volatile LAS unsigned* MISC = (volatile LAS unsigned*)(lds + LDSCTL_OFF);
    XcdBarrier bar = xcd_barrier_post((unsigned*)ctl + CW_BAR + a.bar_region * BAR_STRIDE, MISC + 8);
    const int lo = a.ph_lo, hi = a.ph_hi;
#define IN(k) (lo <= (k) && (k) < hi)
#define SEAM(k) do { if (IN(k) && IN((k) + 1)) xcd_barrier(bar); } while (0)
    float* X = (float*)(ws + WS_X); bf16* XB = (bf16*)(ws + WS_XB); bf16* PROJ = (bf16*)(ws + WS_PROJ); bf16* HEADS = (bf16*)(ws + WS_HEADS);
    bf16* UB = (bf16*)(ws + WS_R1); bf16* HB = (bf16*)(ws + WS_H); float* GATES = (float*)(ws + WS_GATES);

    if (IN(0)) p0_prologue(a, lds, vcu, G, wave, lane, tid);
    SEAM(0);
    for (int layer = 0; layer < DEPTH; ++layer) {
        const int j = layer >> 1, odd = layer & 1, pb = 1 + layer * 8;
        const int NGW = G * NWAVES, NGT = G * NTHREADS;
#define LANE_VARS int tl = threadIdx.x; asm volatile("" : "+v"(tl)); const int lane = tl & 63, gw = vcu * NWAVES + __builtin_amdgcn_readfirstlane(tl >> 6), gt = vcu * NTHREADS + tl; (void)lane; (void)gw; (void)gt;
        if (IN(pb)) {
            LANE_VARS
            const bf16* WG = (const bf16*)(ws + WS_WG) + (size_t)(odd ? 2 + j : j) * 32 * DM;
            gates_phase(XB, WG, odd ? a.in[6] + (size_t)j * ML_IN + 6144 : a.in[2] + (size_t)j * ATT_IN + 3072, odd ? 16 : 8, GATES, gw, NGW, lane);
            const int N = odd ? ML_N : ATT_N;
            pg8::Gemm g{XB, odd ? (const bf16*)(ws + WS_WMIN) + (size_t)j * ML_N * DM : (const bf16*)(ws + WS_WAIN) + (size_t)j * ATT_N * DM, MTOK, N, DM};
            pg8::StaticOrder S; S.init(MTOK, N, G, bx);
            pg8::EpiProj E{PROJ, N, odd ? a.in[6] + (size_t)j * ML_IN : (const float*)(ws + WS_BIASA) + (size_t)j * ATT_N, odd ? 0 : A_SQ / 256, odd ? 0 : A_SV / 256, (const float*)(ws + WS_ROPE)};
            pg8::gemm_phase<pg8::EpiProj, pg8::StaticOrder, true, true>(lds, g, S, E);
        }
        SEAM(pb);
        if (IN(pb + 1)) {
#if !NAIVE_ATTN
            if (!odd) att::attn_phase(PROJ, GATES, a.in[3] + (size_t)j * SWAQ, HEADS, (char*)lds_raw, bx, G);
#endif
#if !NAIVE_MLSTM
            if (odd) MLSTM_PHASE
#endif
        }
        SEAM(pb + 1);
        if (IN(pb + 2)) {
            pg8::Gemm g{HEADS, odd ? (const bf16*)(ws + WS_WMOUT) + (size_t)j * DM * DM : (const bf16*)(ws + WS_WAOUT) + (size_t)j * DM * DM, MTOK, DM, DM};
            pg8::StaticOrder S; S.init(MTOK, DM, G, bx);
            pg8::EpiResid E{X, DM, DN_ALPHA};
            pg8::gemm_phase<pg8::EpiResid, pg8::StaticOrder, true, true>(lds, g, S, E);
        }
        SEAM(pb + 2);
        if (IN(pb + 3)) { LANE_VARS ln_phase(X, X, XB, a.in[12] + (size_t)layer * DM, a.in[13] + (size_t)layer * DM, gw, NGW, lane); }
        SEAM(pb + 3);
        if (IN(pb + 4)) {
            pg8::Gemm g{XB, (const bf16*)(ws + WS_WUP) + (size_t)layer * UPN * DM, MTOK, UPN, DM};
            pg8::StaticOrder S; S.init(MTOK, UPN, G, bx);
            pg8::EpiStoreBf16 E{UB, UPN};
            pg8::gemm_phase<pg8::EpiStoreBf16, pg8::StaticOrder, true, true>(lds, g, S, E);
        }
        SEAM(pb + 4);
        if (IN(pb + 5)) { LANE_VARS conv_phase(UB, HB, (const float*)(ws + WS_CONVW) + (size_t)layer * 3 * UPN, (const float*)(ws + WS_CONVB) + (size_t)layer * UPN, gt, NGT); }
        SEAM(pb + 5);
        if (IN(pb + 6)) {
            pg8::Gemm g{HB, (const bf16*)(ws + WS_WDN) + (size_t)layer * DM * DFF, MTOK, DM, DFF};
            pg8::StaticOrder S; S.init(MTOK, DM, G, bx);
            pg8::EpiResid E{X, DM, DN_ALPHA};
            pg8::gemm_phase<pg8::EpiResid, pg8::StaticOrder, true, true>(lds, g, S, E);
        }
        SEAM(pb + 6);
        if (IN(pb + 7)) { LANE_VARS const bool lastl = layer == DEPTH - 1; ln_phase(X, lastl ? a.out : X, lastl ? (bf16*)nullptr : XB, a.in[14] + (size_t)layer * DM, a.in[15] + (size_t)layer * DM, gw, NGW, lane); }
        SEAM(pb + 7);
    }
#undef IN
#undef LANE_VARS
#undef SEAM
}


#if NAIVE_ATTN || NAIVE_MLSTM
__global__ void naive_fox_c(const float* GATES, float* C) {
    const int i = blockIdx.x * blockDim.x + threadIdx.x; if (i >= NBATCH * FOXH) return;
    const int b = i / FOXH, h = i % FOXH; double acc = 0.0;
    for (int t = 0; t < SEQ; ++t) { acc += (double)log_sigmoid(GATES[(size_t)(b * SEQ + t) * 16 + h]); C[(size_t)i * SEQ + t] = (float)acc; }
}
__global__ __launch_bounds__(64) void naive_attn(const bf16* PROJ, const float* C, const float* sinks, bf16* HEADS) {
    __shared__ float lg[SEQ];
    const int lane = threadIdx.x, id = blockIdx.x;
    const int t = id % SEQ, hd = (id / SEQ) % 16, b = id / (SEQ * 16);
    const bool fox = hd < 8;
    const int qc = fox ? A_FQ + hd * 128 : A_SQ + (hd - 8) * 128, kc = fox ? A_FK + hd * 128 : A_SK + ((hd - 8) / 4) * 128, vc = fox ? A_FV + hd * 128 : A_SV + ((hd - 8) / 4) * 128;
    const bf16* qp = PROJ + (size_t)(b * SEQ + t) * ATT_N + qc;
    v4u q[16];
#pragma unroll
    for (int i = 0; i < 16; ++i) q[i] = *(const v4u*)(qp + 8 * i);
    const int lo = fox ? 0 : (t - (SWAW - 1) > 0 ? t - (SWAW - 1) : 0);
    const float ct = fox ? C[(size_t)(b * FOXH + hd) * SEQ + t] : 0.f;
    float mx = -3.0e38f;
    for (int s = lo + lane; s <= t; s += 64) {
        const bf16* kp = PROJ + (size_t)(b * SEQ + s) * ATT_N + kc; float dot = 0.f;
#pragma unroll
        for (int i = 0; i < 16; ++i) { const v4u kv = *(const v4u*)(kp + 8 * i);
#pragma unroll
            for (int e = 0; e < 4; ++e) dot += bflo(q[i][e]) * bflo(kv[e]) + bfhi(q[i][e]) * bfhi(kv[e]); }
        float lgt = dot * 0.08838834764831845f; if (fox) lgt += ct - C[(size_t)(b * FOXH + hd) * SEQ + s];
        lg[s - lo] = lgt; mx = fmaxf(mx, lgt);
    }
    mx = wave_max(mx);
    const float sink = fox ? 0.f : sinks[hd - 8];
    if (!fox) mx = fmaxf(mx, sink);
    float sum = 0.f;
    for (int s = lo + lane; s <= t; s += 64) { const float p = expf(lg[s - lo] - mx); lg[s - lo] = p; sum += p; }
    sum = wave_sum(sum); if (!fox) sum += expf(sink - mx);
    __syncthreads();
    float a0 = 0.f, a1 = 0.f;
    for (int s = lo; s <= t; ++s) { const float p = lg[s - lo]; const unsigned w = *(const unsigned*)(PROJ + (size_t)(b * SEQ + s) * ATT_N + vc + 2 * lane); a0 += p * bflo(w); a1 += p * bfhi(w); }
    const float inv = 1.f / sum;
    *(unsigned*)(HEADS + (size_t)(b * SEQ + t) * DM + hd * 128 + 2 * lane) = pk2(a0 * inv, a1 * inv);
}
__global__ __launch_bounds__(320) void naive_mlstm(const bf16* PROJ, const float* GATES, bf16* HEADS) {
    __shared__ float sk[128], sq[128], sdot[1];
    const int b = blockIdx.x / MLH, h = blockIdx.x % MLH, tid = threadIdx.x;
    float Cr[128];
#pragma unroll
    for (int d = 0; d < 128; ++d) Cr[d] = 0.f;
    float m = 0.f;
    for (int t = 0; t < SEQ; ++t) {
        const size_t row = (size_t)(b * SEQ + t);
        if (tid < 128) sk[tid] = bf2f(PROJ[row * ML_N + L_K + h * 128 + tid]) * 0.08838834764831845f;
        else if (tid < 256) sq[tid - 128] = bf2f(PROJ[row * ML_N + L_Q + h * 128 + tid - 128]);
        const float ip = GATES[row * 16 + h], fp = GATES[row * 16 + 8 + h];
        const float lf = log_sigmoid(fp), mn = fmaxf(lf + m, ip), fC = expf(lf + m - mn), iw = expf(ip - mn); m = mn;
        const float vv = tid < 256 ? bf2f(PROJ[row * ML_N + L_V + h * 256 + tid]) : 1.0f;
        __syncthreads();
        float num = 0.f; const float iv = iw * vv;
#pragma unroll
        for (int d = 0; d < 128; ++d) { Cr[d] = fC * Cr[d] + iv * sk[d]; num += Cr[d] * sq[d]; }
        if (tid == 256) sdot[0] = num;
        __syncthreads();
        if (tid < 256) { const float den = fmaxf(fabsf(sdot[0]), expf(-m)); const float hh = num / den; const float o = bf2f(PROJ[row * ML_N + L_O + h * 256 + tid]);
            HEADS[row * DM + h * 256 + tid] = (bf16)f2bf(hh / (1.f + expf(-o))); }
    }
}
#endif


static void launch_mega(Args a, int lo, int hi, int region, int grid, hipStream_t stream) {
    a.ph_lo = lo; a.ph_hi = hi; a.bar_region = region; a.pad = 0;
    hipLaunchKernelGGL(mega, dim3(grid), dim3(NTHREADS), LDS_BYTES, stream, a);
    const hipError_t le = hipPeekAtLastError();
    if (le != hipSuccess) fprintf(stderr, "kernel_launch: mega[%d,%d) failed: %s\n", lo, hi, hipGetErrorName(le));
}
extern "C" void kernel_launch(void* const* d_in, const int* in_sizes, int n_in, void* d_out, int out_size, void* d_ws, size_t ws_size, hipStream_t stream) {
    static int grid = 0;
    if (grid == 0) {
        if (n_in != 16 || in_sizes[0] != MTOK * DM || out_size != MTOK * DM || ws_size < WS_NEED) {
            fprintf(stderr, "kernel_launch: unexpected shapes (n_in %d, in0 %d, out %d, ws %zu < %zu); nothing launched\n", n_in, n_in > 0 ? in_sizes[0] : -1, out_size, ws_size, (size_t)WS_NEED); grid = -1; return; }
        int dev = 0, cus = 0, per_cu = 0;
        if (hipGetDevice(&dev) != hipSuccess || hipDeviceGetAttribute(&cus, hipDeviceAttributeMultiprocessorCount, dev) != hipSuccess) { fprintf(stderr, "kernel_launch: device query failed\n"); grid = -1; return; }
        if (hipFuncSetAttribute((const void*)mega, hipFuncAttributeMaxDynamicSharedMemorySize, LDS_BYTES) != hipSuccess) { fprintf(stderr, "kernel_launch: hipFuncSetAttribute failed\n"); grid = -1; return; }
        if (hipOccupancyMaxActiveBlocksPerMultiprocessor(&per_cu, (const void*)mega, NTHREADS, LDS_BYTES) != hipSuccess || per_cu < 1)
            fprintf(stderr, "kernel_launch: note: occupancy query reports %d workgroups per CU\n", per_cu);
        (void)hipGetLastError();
        grid = cus;
    }
    if (grid < 0) return;
    if (hipMemsetAsync((char*)d_ws + WS_CTL, 0, CTL_ZERO_BYTES, stream) != hipSuccess) { fprintf(stderr, "kernel_launch: memset failed\n"); return; }
    Args a{};
    for (int i = 0; i < 16; ++i) a.in[i] = (const float*)d_in[i];
    a.out = (float*)d_out; a.ws = (unsigned char*)d_ws;
    unsigned char* ws = (unsigned char*)d_ws; (void)ws;
    int region = 0, lo = 0;
    for (int layer = 0; layer < DEPTH; ++layer) {
        const int pb = 1 + layer * 8, j = layer >> 1; (void)j;
#if NAIVE_ATTN
        if ((layer & 1) == 0) {
            launch_mega(a, lo, pb + 1, region++, grid, stream); lo = pb + 2;
            hipLaunchKernelGGL(naive_fox_c, dim3(1), dim3(64), 0, stream, (const float*)(ws + WS_GATES), (float*)(ws + WS_FOXC));
            hipLaunchKernelGGL(naive_attn, dim3(NBATCH * 16 * SEQ), dim3(64), 0, stream, (const bf16*)(ws + WS_PROJ), (const float*)(ws + WS_FOXC), a.in[3] + (size_t)j * SWAQ, (bf16*)(ws + WS_HEADS));
        }
#endif
#if NAIVE_MLSTM
        if ((layer & 1) == 1) {
            launch_mega(a, lo, pb + 1, region++, grid, stream); lo = pb + 2;
            hipLaunchKernelGGL(naive_mlstm, dim3(NBATCH * MLH), dim3(320), 0, stream, (const bf16*)(ws + WS_PROJ), (const float*)(ws + WS_GATES), (bf16*)(ws + WS_HEADS));
        }
#endif
    }
    launch_mega(a, lo, 1 + DEPTH * 8, region++, grid, stream);
}
```

```cpp
#include <hip/hip_runtime.h>
#include <cstdio>
#include <cstdint>

constexpr int DM = 2048, NBATCH = 4, SEQ = 4096, MTOK = NBATCH * SEQ, DEPTH = 4;
constexpr int HD = 128, FOXH = 8, SWAQ = 8, SWAKV = 2, SWAW = 128;
constexpr int ATT_IN = 4616, ATT_N = 4608;
constexpr int ML_IN = 6160, ML_N = 6144;
constexpr int MLH = 8, MLDK = 128, MLDV = 256, MLCH = 64;
constexpr int DFF = 5632, UPN = 2 * DFF;
constexpr float LN_EPS = 1e-5f;
constexpr float DN_ALPHA = 1.6817928305074290f;
constexpr int A_FQ = 0, A_FK = 1024, A_FV = 2048, A_SQ = 3072, A_SK = 4096, A_SV = 4352;
constexpr int L_Q = 0, L_K = 1024, L_V = 2048, L_O = 4096;

#ifndef REP_ATTN
#define REP_ATTN 1
#endif
#ifndef REP_MLSTM
#define REP_MLSTM 1
#endif
#ifndef REP_CONV
#define REP_CONV 1
#endif
#ifndef FUSE_CONV
#define FUSE_CONV 1
#endif
#ifndef NAIVE_ATTN
#define NAIVE_ATTN 0
#endif
#ifndef NAIVE_MLSTM
#define NAIVE_MLSTM 0
#endif
namespace pg8 {
#define PG8_LAS __attribute__((address_space(3)))
typedef unsigned short bf16_t;
typedef short bf16x8 __attribute__((ext_vector_type(8)));
typedef float f32x4 __attribute__((ext_vector_type(4)));
typedef unsigned u32x4 __attribute__((ext_vector_type(4)));
constexpr int BM = 256, BK = 64, HALF = 128, HTB = HALF * BK * 2  , STAGE_BYTES = 8 * HTB, NXCD = 8, WGM = 8;

__host__ __device__ __forceinline__ int lds_byte(int r, int c) { const int st = (r >> 4) * 2 + (c >> 5), rr = r & 15, cc = c & 31, ob = rr * 64 + cc * 2; return st * 1024 + (ob ^ (((ob >> 9) & 1) << 5)); }
__host__ __device__ __forceinline__ void stage_rc(int b, int& R, int& C) { const int st = b / 1024, sb = b % 1024, swz = sb ^ (((sb >> 9) & 1) << 5); R = (st >> 1) * 16 + swz / 64; C = (st & 1) * 32 + (swz % 64) / 2; }
__host__ __device__ __forceinline__ int perm32(int rho) { const int n = rho >> 4, i = rho & 15; return 8 * (i >> 2) + 4 * n + (i & 3); }

struct Unit { int pm, pn; };
struct Gemm { const bf16_t* A; const bf16_t* Bt; int M, N, K; };

struct StaticOrder {
    int nM, nN, nwg, G, c;
    __host__ __device__ void init(int M, int N, int G_, int c_) { nM = M / BM; nN = N / BM; nwg = nM * nN; G = G_; c = c_; }
    __host__ __device__ bool next(int i, Unit& u) const {
        const long L = (long)i * G + c; if (L >= nwg) return false;
        int wgid = (int)L; { const int q = nwg / NXCD, r = nwg % NXCD, xcd = wgid % NXCD, off = wgid / NXCD; wgid = (xcd < r ? xcd * (q + 1) : r * (q + 1) + (xcd - r) * q) + off; }
        const int nig = WGM * nN, gid = wgid / nig, fm = gid * WGM, gsz = (nM - fm) < WGM ? (nM - fm) : WGM;
        u.pm = fm + ((wgid % nig) % gsz); u.pn = (wgid % nig) / gsz; return true;
    }
    __device__ __forceinline__ void a_ready(const Unit&) const {}
    __device__ __forceinline__ void done(const Unit&) const {}
};
__device__ __forceinline__ unsigned cvt_pk_bf16(float lo, float hi) { unsigned r; asm volatile("v_cvt_pk_bf16_f32 %0, %1, %2" : "=v"(r) : "v"(lo), "v"(hi)); return r; }
typedef float f32x2 __attribute__((ext_vector_type(2)));
typedef unsigned u32x2 __attribute__((ext_vector_type(2)));
struct EpiStoreBf16 {
    static constexpr bool PERM = true, AFTER_DRAIN = false;
    bf16_t* O; int ldc;
    __device__ __forceinline__ void operator()(const f32x4 (&acc)[2][2][4][2], const Unit& u, int wr, int wc, int fr, int fq) const {
        const int row0 = u.pm * BM + wr * 64 + fr, col0 = u.pn * BM + wc * 32 + 8 * fq;
#pragma unroll
        for (int ai = 0; ai < 2; ++ai)
#pragma unroll
            for (int m = 0; m < 4; ++m) { bf16_t* rowp = O + (size_t)(row0 + ai * HALF + m * 16) * ldc + col0;
#pragma unroll
                for (int bj = 0; bj < 2; ++bj) { const f32x4 v0 = acc[ai][bj][m][0], v1 = acc[ai][bj][m][1];
                    u32x4 w; w.x = cvt_pk_bf16(v0[0], v0[1]); w.y = cvt_pk_bf16(v0[2], v0[3]); w.z = cvt_pk_bf16(v1[0], v1[1]); w.w = cvt_pk_bf16(v1[2], v1[3]);
                    *(u32x4*)(rowp + bj * HALF) = w; } }
    }
};
struct EpiProj {
    static constexpr bool PERM = true, AFTER_DRAIN = false;
    bf16_t* O; int ldc; const float* bias; int rope_lo, rope_hi; const float* rope;
    __device__ __forceinline__ void operator()(const f32x4 (&acc)[2][2][4][2], const Unit& u, int wr, int wc, int fr, int fq) const {
        const int row0 = u.pm * BM + wr * 64 + fr, col0 = u.pn * BM + wc * 32 + 8 * fq;
        const bool rp = (u.pn >= rope_lo) && (u.pn < rope_hi);
        f32x4 bv[2][2];
#pragma unroll
        for (int bj = 0; bj < 2; ++bj)
#pragma unroll
            for (int n = 0; n < 2; ++n) bv[bj][n] = *(const f32x4*)(bias + col0 + bj * HALF + 4 * n);
        const int f0 = wc * 16 + 4 * fq;
#pragma unroll
        for (int ai = 0; ai < 2; ++ai)
#pragma unroll
            for (int m = 0; m < 4; ++m) { const int row = row0 + ai * HALF + m * 16; bf16_t* rowp = O + (size_t)row * ldc + col0;
                f32x4 cs0 = (f32x4){1.f, 0.f, 1.f, 0.f}, cs1 = cs0;
                if (rp) { const float* rt = rope + ((size_t)(row & (4096 - 1)) * 64 + f0) * 2; cs0 = *(const f32x4*)rt; cs1 = *(const f32x4*)(rt + 4); }
#pragma unroll
                for (int bj = 0; bj < 2; ++bj) { f32x4 v0 = acc[ai][bj][m][0] + bv[bj][0], v1 = acc[ai][bj][m][1] + bv[bj][1];
                    if (rp) { const f32x4 a = v0, b = v1;
                        v0[0] = a[0] * cs0[0] - a[1] * cs0[1]; v0[1] = a[1] * cs0[0] + a[0] * cs0[1];
                        v0[2] = a[2] * cs0[2] - a[3] * cs0[3]; v0[3] = a[3] * cs0[2] + a[2] * cs0[3];
                        v1[0] = b[0] * cs1[0] - b[1] * cs1[1]; v1[1] = b[1] * cs1[0] + b[0] * cs1[1];
                        v1[2] = b[2] * cs1[2] - b[3] * cs1[3]; v1[3] = b[3] * cs1[2] + b[2] * cs1[3]; }
                    u32x4 w; w.x = cvt_pk_bf16(v0[0], v0[1]); w.y = cvt_pk_bf16(v0[2], v0[3]); w.z = cvt_pk_bf16(v1[0], v1[1]); w.w = cvt_pk_bf16(v1[2], v1[3]);
                    *(u32x4*)(rowp + bj * HALF) = w; } }
    }
};
struct EpiResid {
    static constexpr bool PERM = false, AFTER_DRAIN = false;
    float* X; int ldc; float alpha;
    __device__ __forceinline__ void operator()(const f32x4 (&acc)[2][2][4][2], const Unit& u, int wr, int wc, int fr, int fq) const {
        const int row0 = u.pm * BM + wr * 64 + fr, col0 = u.pn * BM + wc * 32 + 4 * fq;
#pragma unroll
        for (int ai = 0; ai < 2; ++ai)
#pragma unroll
            for (int m = 0; m < 4; ++m) { float* rowp = X + (size_t)(row0 + ai * HALF + m * 16) * ldc + col0;
                f32x4 xv[2][2];
#pragma unroll
                for (int bj = 0; bj < 2; ++bj)
#pragma unroll
                    for (int n = 0; n < 2; ++n) xv[bj][n] = *(const f32x4*)(rowp + bj * HALF + n * 16);
#pragma unroll
                for (int bj = 0; bj < 2; ++bj)
#pragma unroll
                    for (int n = 0; n < 2; ++n) *(f32x4*)(rowp + bj * HALF + n * 16) = xv[bj][n] * alpha + acc[ai][bj][m][n];
                asm volatile("" ::: "memory"); }
    }
};


__device__ __forceinline__ float dpp_ror1(float v) { return __builtin_bit_cast(float, __builtin_amdgcn_update_dpp(0, __builtin_bit_cast(int, v), 0x121, 0xf, 0xf, false)); }
__device__ __forceinline__ float dpp_ror2(float v) { return __builtin_bit_cast(float, __builtin_amdgcn_update_dpp(0, __builtin_bit_cast(int, v), 0x122, 0xf, 0xf, false)); }
struct EpiConv {
    static constexpr bool PERM = true, AFTER_DRAIN = false;
    bf16_t* H; const float* cw; const float* cb; float* halo; float* raw0; PG8_LAS float* xch;
    __device__ __forceinline__ void operator()(const f32x4 (&acc)[2][2][4][2], const Unit& u, int wr, int wc, int fr_, int fq_) const {
        constexpr int UPW = 11264, HW = 5632;
        int fr = fr_, fq = fq_; asm volatile("" : "+v"(fr), "+v"(fq));
        const int pc0 = u.pn * BM + wc * 32 + 8 * fq;
        if (fr >= 14) {
#pragma unroll
            for (int ai = 0; ai < 2; ++ai) { PG8_LAS f32x4* dst = (PG8_LAS f32x4*)(xch + ((((ai * 2 + wr) * 4 + wc) * 2 + (fr - 14)) * 4 + fq) * 16);
                dst[0] = acc[ai][0][3][0]; dst[1] = acc[ai][0][3][1]; dst[2] = acc[ai][1][3][0]; dst[3] = acc[ai][1][3][1]; }
            if (wr == 1) { float* hp = halo + ((size_t)u.pm * 2 + (fr - 14)) * UPW + pc0;
                *(f32x4*)hp = acc[1][0][3][0]; *(f32x4*)(hp + 4) = acc[1][0][3][1]; *(f32x4*)(hp + 128) = acc[1][1][3][0]; *(f32x4*)(hp + 132) = acc[1][1][3][1]; }
        }
        const bool seq0 = (u.pm & 15) == 0;
        if (wr == 0 && fr < 2 && !seq0) { float* rp = raw0 + ((size_t)u.pm * 2 + fr) * UPW + pc0;
            *(f32x4*)rp = acc[0][0][0][0]; *(f32x4*)(rp + 4) = acc[0][0][0][1]; *(f32x4*)(rp + 128) = acc[0][1][0][0]; *(f32x4*)(rp + 132) = acc[0][1][0][1]; }
        asm volatile("s_waitcnt lgkmcnt(0)" ::: "memory"); __builtin_amdgcn_s_barrier(); asm volatile("" ::: "memory");
        f32x4 w[3][2][2], bq[2][2];
#pragma unroll
        for (int j = 0; j < 3; ++j)
#pragma unroll
            for (int bj = 0; bj < 2; ++bj)
#pragma unroll
                for (int n = 0; n < 2; ++n) w[j][bj][n] = *(const f32x4*)(cw + (size_t)j * UPW + pc0 + bj * HALF + 4 * n);
#pragma unroll
        for (int bj = 0; bj < 2; ++bj)
#pragma unroll
            for (int n = 0; n < 2; ++n) bq[bj][n] = *(const f32x4*)(cb + pc0 + bj * HALF + 4 * n);
        const bool f15 = fr == 15, f14 = fr >= 14;
#pragma unroll
        for (int ai = 0; ai < 2; ++ai) {
            f32x4 prev[2][2];
#pragma unroll
            for (int bj = 0; bj < 2; ++bj)
#pragma unroll
                for (int n = 0; n < 2; ++n) prev[bj][n] = (f32x4){0.f, 0.f, 0.f, 0.f};
            if (fr >= 14 && (wr == 1 || ai == 1)) { const int sai = wr == 1 ? ai : 0, swr = wr == 1 ? 0 : 1;
                const PG8_LAS f32x4* src = (const PG8_LAS f32x4*)(xch + ((((sai * 2 + swr) * 4 + wc) * 2 + (fr - 14)) * 4 + fq) * 16);
                prev[0][0] = src[0]; prev[0][1] = src[1]; prev[1][0] = src[2]; prev[1][1] = src[3]; }
#pragma unroll
            for (int m = 0; m < 4; ++m) {
                f32x4 c[2][2];
#pragma unroll
                for (int bj = 0; bj < 2; ++bj)
#pragma unroll
                    for (int n = 0; n < 2; ++n) {
                        const f32x4 cur = acc[ai][bj][m][n], pv = m == 0 ? prev[bj][n] : acc[ai][bj][m - 1][n];
#pragma unroll
                        for (int i = 0; i < 4; ++i) { const float m1 = f15 ? pv[i] : cur[i], m2 = f14 ? pv[i] : cur[i];
                            const float u1 = dpp_ror1(m1), u2 = dpp_ror2(m2);
                            c[bj][n][i] = bq[bj][n][i] + w[0][bj][n][i] * u2 + w[1][bj][n][i] * u1 + w[2][bj][n][i] * cur[i]; } }
                u32x4 o;
#pragma unroll
                for (int n = 0; n < 2; ++n) { float h[4];
#pragma unroll
                    for (int i = 0; i < 4; ++i) { const float g = c[0][n][i]; h[i] = g * __builtin_amdgcn_rcpf(1.f + __builtin_amdgcn_exp2f(-1.4426950408889634f * g)) * c[1][n][i]; }
                    o[2 * n] = cvt_pk_bf16(h[0], h[1]); o[2 * n + 1] = cvt_pk_bf16(h[2], h[3]); }
                const bool skip = (ai == 0 && m == 0 && wr == 0 && fr < 2 && !seq0);
                if (!skip) *(u32x4*)(H + (size_t)(u.pm * BM + ai * HALF + wr * 64 + m * 16 + fr) * HW + u.pn * HALF + wc * 32 + 8 * fq) = o;
            }
        }
    }
};
template <class Epi, class Sched, bool ALIGN_EPI = false, bool SP2 = false>
__device__ __forceinline__ void gemm_phase(PG8_LAS unsigned char* lds, const Gemm g, const Sched& S, const Epi& E) {
    int tid_l = threadIdx.x; asm volatile("" : "+v"(tid_l));
    const int tid = tid_l, wid = __builtin_amdgcn_readfirstlane(tid >> 6), lane = tid & 63, wr = wid >> 2, wc = wid & 3, fr = lane & 15, fq = lane >> 4;
    const int K = g.K, nt = K / BK;
    unsigned voffA[2], voffB[2];
#pragma unroll
    for (int i = 0; i < 2; ++i) { int R, C; stage_rc(tid * 16 + i * 8192, R, C); const int Rb = Epi::PERM ? ((R & ~31) + perm32(R & 31)) : R;
        voffA[i] = (unsigned)(R * K + C) * 2u; voffB[i] = (unsigned)(Rb * K + C) * 2u; }
    const size_t kstep = (size_t)(BK * 2);
    const size_t hstep = (size_t)HALF * K * 2;
    const size_t tstep = 2 * hstep;
    const unsigned ldsw = (unsigned)wid * 1024u;
    const int aoff = lds_byte(wr * 64 + fr, fq * 8), boff = lds_byte(wc * 32 + fr, fq * 8);
#define PG8_SA(b, h) (((b) * 2 + (h)) * HTB)
#define PG8_SB(b, h) ((4 + (b) * 2 + (h)) * HTB)
#define PG8_STAGE(bufoff, gbase, voff) do { _Pragma("unroll") for (int _i = 0; _i < 2; ++_i) \
        __builtin_amdgcn_global_load_lds((const unsigned*)((const char*)(gbase) + (voff)[_i]), (PG8_LAS unsigned*)(lds + (bufoff) + ldsw + _i * 8192), 16, 0, 0); } while (0)
#define PG8_LDA(dst, b, h) do { _Pragma("unroll") for (int m = 0; m < 4; ++m) _Pragma("unroll") for (int k = 0; k < 2; ++k) dst[m][k] = *(const PG8_LAS bf16x8*)(lds + PG8_SA(b, h) + aoff + m * 2048 + k * 1024); } while (0)
#define PG8_LDB(dst, b, h) do { _Pragma("unroll") for (int n = 0; n < 2; ++n) _Pragma("unroll") for (int k = 0; k < 2; ++k) dst[n][k] = *(const PG8_LAS bf16x8*)(lds + PG8_SB(b, h) + boff + n * 2048 + k * 1024); } while (0)
#define PG8_MMA(ai, bj, At, Bt) do { __builtin_amdgcn_s_setprio(1); _Pragma("unroll") for (int m = 0; m < 4; ++m) _Pragma("unroll") for (int n = 0; n < 2; ++n) _Pragma("unroll") for (int k = 0; k < 2; ++k) \
        acc[ai][bj][m][n] = __builtin_amdgcn_mfma_f32_16x16x32_bf16(Bt[n][k], At[m][k], acc[ai][bj][m][n], 0, 0, 0); __builtin_amdgcn_s_setprio(0); } while (0)
#define PG8_WAIT_V(n) asm volatile("s_waitcnt vmcnt(" #n ")" ::: "memory")
#define PG8_WAIT_L(n) asm volatile("s_waitcnt lgkmcnt(" #n ")" ::: "memory")
#define PG8_BAR __builtin_amdgcn_s_barrier()
#define PG8_SCHED __builtin_amdgcn_sched_barrier(0)
    Unit cur, nxt; int ui = 0;
    if (!S.next(0, cur)) return;
    f32x4 acc[2][2][4][2];
#pragma unroll
    for (int a = 0; a < 2; ++a)
#pragma unroll
        for (int b = 0; b < 2; ++b)
#pragma unroll
            for (int m = 0; m < 4; ++m)
#pragma unroll
                for (int n = 0; n < 2; ++n) acc[a][b][m][n] = (f32x4){0.f, 0.f, 0.f, 0.f};
    bf16x8 At[4][2], B0[2][2], B1[2][2];
    const char* cA = (const char*)g.A + (size_t)cur.pm * tstep; const char* cB = (const char*)g.Bt + (size_t)cur.pn * tstep;
    S.a_ready(cur);
    if constexpr (SP2) {
        PG8_STAGE(PG8_SB(0, 0), cB, voffB); PG8_STAGE(PG8_SB(0, 1), cB + hstep, voffB); PG8_STAGE(PG8_SA(0, 0), cA, voffA); PG8_STAGE(PG8_SA(0, 1), cA + hstep, voffA);
        if (wr == 1) PG8_BAR;
        PG8_WAIT_V(2); PG8_BAR;
        PG8_STAGE(PG8_SB(1, 0), cB + kstep, voffB); PG8_STAGE(PG8_SA(1, 0), cA + kstep, voffA); PG8_STAGE(PG8_SB(1, 1), cB + hstep + kstep, voffB);
        PG8_WAIT_V(6); PG8_BAR;
    } else {
        PG8_STAGE(PG8_SB(0, 0), cB, voffB); PG8_STAGE(PG8_SA(0, 0), cA, voffA); PG8_STAGE(PG8_SB(0, 1), cB + hstep, voffB); PG8_STAGE(PG8_SA(0, 1), cA + hstep, voffA);
        if (wr == 1) PG8_BAR;
        PG8_WAIT_V(4); PG8_BAR;
        PG8_STAGE(PG8_SB(1, 0), cB + kstep, voffB); PG8_STAGE(PG8_SA(1, 0), cA + kstep, voffA); PG8_STAGE(PG8_SB(1, 1), cB + hstep + kstep, voffB);
        PG8_WAIT_V(6); PG8_BAR;
    }
    for (;;) {
        const bool has_next = S.next(ui + 1, nxt);
        const char* nA = has_next ? (const char*)g.A + (size_t)nxt.pm * tstep : cA; const char* nB = has_next ? (const char*)g.Bt + (size_t)nxt.pn * tstep : cB;
        for (int t = 0; t < nt; t += 2) {
            const bool last = (t == nt - 2);
            const char* a1 = cA + (size_t)(t + 1) * kstep;
            const char* a2 = last ? nA : cA + (size_t)(t + 2) * kstep; const char* b2 = last ? nB : cB + (size_t)(t + 2) * kstep;
            const char* a3 = a2 + kstep; const char* b3 = b2 + kstep;
            if (last && has_next) S.a_ready(nxt);
            if constexpr (SP2) {
            PG8_LDB(B0, 0, 0); PG8_LDB(B1, 0, 1); PG8_SCHED; PG8_LDA(At, 0, 0); PG8_STAGE(PG8_SA(1, 1), a1 + hstep, voffA);
            PG8_WAIT_V(8); PG8_WAIT_L(0); PG8_BAR; PG8_MMA(0, 0, At, B0); PG8_MMA(0, 1, At, B1); PG8_BAR; PG8_SCHED;
            PG8_LDA(At, 0, 1); PG8_STAGE(PG8_SB(0, 0), b2, voffB); PG8_STAGE(PG8_SB(0, 1), b2 + hstep, voffB); PG8_STAGE(PG8_SA(0, 0), a2, voffA);
            PG8_WAIT_V(8); PG8_WAIT_L(0); PG8_BAR; PG8_MMA(1, 0, At, B0); PG8_MMA(1, 1, At, B1); PG8_BAR; PG8_SCHED;
            PG8_LDB(B0, 1, 0); PG8_LDB(B1, 1, 1); PG8_SCHED; PG8_LDA(At, 1, 0); PG8_STAGE(PG8_SA(0, 1), a2 + hstep, voffA);
            PG8_WAIT_V(8); PG8_WAIT_L(0); PG8_BAR; PG8_MMA(0, 0, At, B0); PG8_MMA(0, 1, At, B1); PG8_BAR; PG8_SCHED;
            PG8_LDA(At, 1, 1); PG8_STAGE(PG8_SB(1, 0), b3, voffB); PG8_STAGE(PG8_SB(1, 1), b3 + hstep, voffB); PG8_STAGE(PG8_SA(1, 0), a3, voffA);
            PG8_WAIT_V(8); PG8_WAIT_L(0); PG8_BAR; PG8_MMA(1, 0, At, B0); PG8_MMA(1, 1, At, B1); PG8_BAR; PG8_SCHED;
            } else {
            PG8_LDB(B0, 0, 0); PG8_SCHED; PG8_LDA(At, 0, 0); PG8_STAGE(PG8_SA(1, 1), a1 + hstep, voffA);
            PG8_WAIT_L(8); PG8_BAR; PG8_WAIT_L(0); PG8_MMA(0, 0, At, B0); PG8_BAR; PG8_SCHED;
            PG8_LDB(B1, 0, 1); PG8_STAGE(PG8_SB(0, 0), b2, voffB);
            PG8_BAR; PG8_WAIT_L(0); PG8_MMA(0, 1, At, B1); PG8_BAR;
            PG8_LDA(At, 0, 1); PG8_STAGE(PG8_SA(0, 0), a2, voffA);
            PG8_BAR; PG8_WAIT_L(0); PG8_MMA(1, 0, At, B0); PG8_BAR; PG8_SCHED;
            PG8_STAGE(PG8_SB(0, 1), b2 + hstep, voffB);
            PG8_WAIT_V(6); PG8_BAR; PG8_MMA(1, 1, At, B1); PG8_BAR;
            PG8_LDB(B0, 1, 0); PG8_SCHED; PG8_LDA(At, 1, 0); PG8_STAGE(PG8_SA(0, 1), a2 + hstep, voffA);
            PG8_WAIT_L(8); PG8_BAR; PG8_WAIT_L(0); PG8_MMA(0, 0, At, B0); PG8_BAR; PG8_SCHED;
            PG8_LDB(B1, 1, 1); PG8_STAGE(PG8_SB(1, 0), b3, voffB);
            PG8_BAR; PG8_WAIT_L(0); PG8_MMA(0, 1, At, B1); PG8_BAR;
            PG8_LDA(At, 1, 1); PG8_STAGE(PG8_SA(1, 0), a3, voffA);
            PG8_BAR; PG8_WAIT_L(0); PG8_MMA(1, 0, At, B0); PG8_BAR; PG8_SCHED;
            PG8_STAGE(PG8_SB(1, 1), b3 + hstep, voffB);
            PG8_WAIT_V(6); PG8_BAR; PG8_MMA(1, 1, At, B1); PG8_BAR;
            }
        }
        if constexpr (ALIGN_EPI) { if (wr == 0) PG8_BAR; }
        if constexpr (!Epi::AFTER_DRAIN) { E(acc, cur, wr, wc, fr, fq); S.done(cur); }
        if (!has_next) break;
#pragma unroll
        for (int a = 0; a < 2; ++a)
#pragma unroll
            for (int b = 0; b < 2; ++b)
#pragma unroll
                for (int m = 0; m < 4; ++m)
#pragma unroll
                    for (int n = 0; n < 2; ++n) acc[a][b][m][n] = (f32x4){0.f, 0.f, 0.f, 0.f};
        cur = nxt; cA = nA; cB = nB; ++ui;
        if constexpr (ALIGN_EPI) { if (wr == 1) PG8_BAR; }
    }
    PG8_WAIT_V(0);
    if constexpr (!ALIGN_EPI) { if (wr == 0) PG8_BAR; }
    PG8_BAR;
    if constexpr (Epi::AFTER_DRAIN) { E.fused(acc, cur, wr, wc, fr, fq, lds, wid, lane); S.done(cur); }
#undef PG8_SA
#undef PG8_SB
#undef PG8_STAGE
#undef PG8_LDA
#undef PG8_LDB
#undef PG8_MMA
#undef PG8_WAIT_V
#undef PG8_WAIT_L
#undef PG8_BAR
#undef PG8_SCHED
}
}

#define GAS __attribute__((address_space(1)))
#define LAS __attribute__((address_space(3)))
typedef unsigned short bf16;
typedef unsigned v4u __attribute__((ext_vector_type(4)));
typedef unsigned v2u __attribute__((ext_vector_type(2)));
typedef float f32x4 __attribute__((ext_vector_type(4)));
typedef float f32x16 __attribute__((ext_vector_type(16)));
typedef short bf16x8 __attribute__((ext_vector_type(8)));
typedef short s16x4 __attribute__((ext_vector_type(4)));
typedef GAS unsigned gu32;
#define RLX_AGENT __ATOMIC_RELAXED, __HIP_MEMORY_SCOPE_AGENT
#define LDS_WAIT() asm volatile("s_waitcnt lgkmcnt(0)" ::: "memory")
#define VM_WAIT() asm volatile("s_waitcnt vmcnt(0)" ::: "memory")
__device__ __forceinline__ unsigned f2bf(float f) { unsigned u = __builtin_bit_cast(unsigned, f); return (u + 0x7fffu + ((u >> 16) & 1u)) >> 16; }
__device__ __forceinline__ unsigned pk2(float lo, float hi) { return f2bf(lo) | (f2bf(hi) << 16); }
__device__ __forceinline__ float bf2f(unsigned short b) { return __builtin_bit_cast(float, (unsigned)b << 16); }
__device__ __forceinline__ float bflo(unsigned w) { return __builtin_bit_cast(float, w << 16); }
__device__ __forceinline__ float bfhi(unsigned w) { return __builtin_bit_cast(float, w & 0xffff0000u); }
__device__ __forceinline__ float wave_sum(float v) {
#pragma unroll
    for (int o = 1; o < 64; o <<= 1) v += __shfl_xor(v, o);
    return v;
}
__device__ __forceinline__ float wave_max(float v) {
#pragma unroll
    for (int o = 1; o < 64; o <<= 1) v = fmaxf(v, __shfl_xor(v, o));
    return v;
}
__device__ __forceinline__ float shfl_idx(float v, int src) { return __builtin_bit_cast(float, __builtin_amdgcn_ds_bpermute(src << 2, __builtin_bit_cast(int, v))); }
__device__ __forceinline__ float wave_sum_l(float v, int lane) {
#pragma unroll
    for (int o = 1; o < 64; o <<= 1) v += shfl_idx(v, lane ^ o);
    return v;
}
__device__ __forceinline__ float log_sigmoid(float x) {
    const float y = __builtin_amdgcn_exp2f(-fabsf(x) * 1.4426950408889634f);
    return fminf(x, 0.f) - __builtin_amdgcn_logf(1.f + y) * 0.6931471805599453f; }

#define XB_TMO      128
#define XB_XCNT(j)  (256  + 64 * (j))
#define XB_XSUB(j)  (1280 + 64 * (j))
#define XB_XGEN(j)  (2304 + 64 * (j))
#define XB_TOP      3328
#define XB_TOPGEN   3392
#define XCD_BAR_WORDS 3456
#define XB_SPIN_CAP (1u << 18)

__device__ __forceinline__ unsigned xb_ld(unsigned* p)              { return __hip_atomic_load(p, __ATOMIC_RELAXED, __HIP_MEMORY_SCOPE_AGENT); }
__device__ __forceinline__ unsigned xb_add(unsigned* p, unsigned v) { return __hip_atomic_fetch_add(p, v, __ATOMIC_RELAXED, __HIP_MEMORY_SCOPE_AGENT); }
__device__ __forceinline__ unsigned xb_xcc_id() { return (unsigned)__builtin_amdgcn_s_getreg((3 << 11) | 20) & 0xFu; }
#define XB_SPIN(cond, bar) do { unsigned _sp = 0; while (cond) { __builtin_amdgcn_s_sleep(1); \
    if ((++_sp & 255u) == 0u) { if (xb_ld(&(bar)[XB_TMO])) break; if (_sp > XB_SPIN_CAP) { atomicAdd(&(bar)[XB_TMO], 1u); break; } } } } while (0)

struct XcdBarrier {
    unsigned* bar; unsigned x;
    volatile LAS unsigned* st;
};

__device__ __forceinline__ XcdBarrier xcd_barrier_post(unsigned* bar, volatile LAS unsigned* st) {
    XcdBarrier b; b.bar = bar; b.x = xb_xcc_id(); b.st = st;
    if (threadIdx.x == 0) (void)xb_add(&bar[XB_XCNT(b.x)], 1u);
    return b;
}
__device__ __forceinline__ void xcd_barrier_complete(unsigned* bar, unsigned x, unsigned& nloc, unsigned& nx) {
    const unsigned G = gridDim.x * gridDim.y * gridDim.z;
    unsigned sum, cnt, mine, sp = 0u;
    for (;;) {
        sum = 0u; cnt = 0u; mine = 0u;
#pragma unroll
        for (unsigned j = 0; j < 16; ++j) { const unsigned c = xb_ld(&bar[XB_XCNT(j)]); sum += c; cnt += (c > 0u) ? 1u : 0u; mine = (j == x) ? c : mine; }
        if (sum == G) break;
        __builtin_amdgcn_s_sleep(1);
        if ((++sp & 255u) == 0u) { if (xb_ld(&bar[XB_TMO])) break; if (sp > XB_SPIN_CAP) { atomicAdd(&bar[XB_TMO], 1u); break; } }
    }
    nloc = mine > 0u ? mine : 1u; nx = cnt > 0u ? cnt : 1u;
}

__device__ __forceinline__ void xcd_barrier(const XcdBarrier& b) {
    asm volatile("s_waitcnt vmcnt(0)" ::: "memory");
    __syncthreads();
    if (threadIdx.x == 0) {
        unsigned* bar = b.bar;
        __builtin_amdgcn_s_waitcnt(0);
        unsigned nloc = b.st[0], nx = b.st[1];
        if (nloc == 0u) { xcd_barrier_complete(bar, b.x, nloc, nx); b.st[0] = nloc; b.st[1] = nx; }
        const unsigned old = xb_add(&bar[XB_XSUB(b.x)], 1u);
        const unsigned gen = old / nloc;
        if (old + 1u == (gen + 1u) * nloc) {
            __builtin_amdgcn_fence(__ATOMIC_RELEASE, "agent");
            asm volatile("s_waitcnt vmcnt(0)" ::: "memory");
            const unsigned og = xb_add(&bar[XB_TOP], 1u);
            const unsigned tg = og / nx;
            if (og + 1u == (tg + 1u) * nx) xb_add(&bar[XB_TOPGEN], 1u);
            else XB_SPIN(xb_ld(&bar[XB_TOPGEN]) == tg, bar);
            __builtin_amdgcn_fence(__ATOMIC_ACQUIRE, "agent");
            xb_add(&bar[XB_XGEN(b.x)], 1u);
            asm volatile("s_waitcnt vmcnt(0)" ::: "memory");
        } else {
            XB_SPIN(xb_ld(&bar[XB_XGEN(b.x)]) == gen, bar);
            __builtin_amdgcn_fence(__ATOMIC_ACQUIRE, "agent");
            asm volatile("s_waitcnt vmcnt(0)" ::: "memory");
        }
    }
    __syncthreads();
}

constexpr size_t MiB = 1u << 20;
constexpr size_t WS_CTL = 0, CTL_ZERO_BYTES = 1 * MiB;
constexpr size_t WS_ROPE = 1 * MiB;
constexpr size_t WS_BIASA = 3 * MiB;
constexpr size_t WS_CONVW = 3 * MiB + 65536;
constexpr size_t WS_CONVB = WS_CONVW + (size_t)4 * 3 * UPN * 4;
constexpr size_t WS_GATES = 4 * MiB;
constexpr size_t WS_WG = 5 * MiB;
constexpr size_t WS_WAIN = 6 * MiB, WS_WAOUT = 42 * MiB, WS_WMIN = 58 * MiB, WS_WMOUT = 106 * MiB, WS_WUP = 122 * MiB, WS_WDN = 298 * MiB;
constexpr size_t WS_X = 386 * MiB;
constexpr size_t WS_XB = 514 * MiB;
constexpr size_t WS_R1 = 578 * MiB;
constexpr size_t WS_PROJ = WS_R1, WS_HEADS = WS_R1 + 192 * MiB;
constexpr size_t WS_H = 930 * MiB;
constexpr size_t WS_END = 1106 * MiB;
constexpr size_t WS_HALO = 1106 * MiB, WS_RAW0 = 1112 * MiB;
constexpr size_t WS_FOXC = 1120 * MiB;
constexpr size_t WS_NEED = 1122 * MiB;
static_assert(WS_CONVB + (size_t)4 * UPN * 4 <= WS_GATES && WS_WAIN + (size_t)2 * ATT_N * DM * 2 <= WS_WAOUT && WS_WMIN + (size_t)2 * ML_N * DM * 2 <= WS_WMOUT &&
              WS_WUP + (size_t)4 * UPN * DM * 2 <= WS_WDN && WS_WDN + (size_t)4 * DM * DFF * 2 <= WS_X && WS_R1 + (size_t)MTOK * UPN * 2 <= WS_H && WS_H + (size_t)MTOK * DFF * 2 <= WS_END, "ws map");
constexpr int CW_BAR = 4096;
constexpr int BAR_STRIDE = 4096;

constexpr int RING_BYTES = 131072;
constexpr int LDSCTL_OFF = RING_BYTES;
constexpr int XCH_OFF = LDSCTL_OFF + 1024;
constexpr int LDS_BYTES = 147456;
constexpr int NWAVES = 8, NTHREADS = 512;

enum { MAP_ID = 0, MAP_ATT = 1, MAP_ATTG = 2, MAP_MLG = 3, MAP_UP = 4 };
__device__ __forceinline__ int src_col(int kind, int n) {
    if (kind == MAP_ATT) {
        if (n < 3072) return n;
        if (n < 4352) { const int base = n < 4096 ? 3072 : 4096, sbase = n < 4096 ? 3080 : 4104, r = n - base, hh = r >> 7, p = r & 127; return sbase + hh * 128 + (p >> 1) + ((p & 1) << 6); }
        return 4360 + (n - 4352);
    }
    if (kind == MAP_ATTG) return n < 8 ? 3072 + n : -1;
    if (kind == MAP_MLG) return n < 16 ? 6144 + n : -1;
    if (kind == MAP_UP) { const int tile = n >> 8, w = n & 255; return w < 128 ? tile * 128 + w : DFF + tile * 128 + (w - 128); }
    return n;
}
__device__ __forceinline__ void tr_item(const float* W, int K, int Nsrc, int Nd, bf16* WT, int kind, LAS float* scr, int item, int lane) {
    const int nblk = Nd / 32, kb = item / nblk, nb = item % nblk, k0 = 64 * kb, n0 = 32 * nb;
    const int c = src_col(kind, n0 + (lane & 31));
#pragma unroll 8
    for (int i = 0; i < 32; ++i) { const int kk = 2 * i + (lane >> 5); scr[kk * 33 + (lane & 31)] = c >= 0 ? W[(size_t)(k0 + kk) * Nsrc + c] : 0.f; }
    LDS_WAIT(); asm volatile("" ::: "memory");
    const int ch = lane & 7;
#pragma unroll
    for (int j = 0; j < 4; ++j) { const int n = (lane >> 3) + 8 * j; const LAS float* s = scr + (8 * ch) * 33 + n;
        v4u o; o.x = pk2(s[0 * 33], s[1 * 33]); o.y = pk2(s[2 * 33], s[3 * 33]); o.z = pk2(s[4 * 33], s[5 * 33]); o.w = pk2(s[6 * 33], s[7 * 33]);
        *(GAS v4u*)(WT + (size_t)(n0 + n) * K + k0 + 8 * ch) = o; }
    LDS_WAIT(); asm volatile("" ::: "memory");
}

struct Args { const float* in[16]; float* out; unsigned char* ws; int ph_lo, ph_hi, bar_region, pad; };

__device__ __forceinline__ void p0_prologue(const Args& a, LAS unsigned char* lds, int vcu, int G, int wave, int lane, int tid) {
    unsigned char* ws = a.ws;
    LAS float* scr = (LAS float*)(lds + wave * 16384);
    const int gw = vcu * NWAVES + wave, NGW = G * NWAVES;
    constexpr int KB = DM / 64;
    constexpr int I_AIN = KB * (ATT_N / 32), I_G = KB * 1, I_OUT = KB * (DM / 32), I_MIN = KB * (ML_N / 32), I_UP = KB * (UPN / 32), I_DN = (DFF / 64) * (DM / 32);
    constexpr int NITEMS = 2 * (I_AIN + I_G + I_OUT + I_MIN + I_G + I_OUT) + 4 * (I_UP + I_DN);
    for (int it = gw; it < NITEMS; it += NGW) {
        int r = it;
        if (r < 4 * I_UP) { const int l = r / I_UP; tr_item(a.in[8] + (size_t)l * DM * UPN, DM, UPN, UPN, (bf16*)(ws + WS_WUP) + (size_t)l * UPN * DM, MAP_UP, scr, r % I_UP, lane); continue; } r -= 4 * I_UP;
        if (r < 4 * I_DN) { const int l = r / I_DN; tr_item(a.in[11] + (size_t)l * DFF * DM, DFF, DM, DM, (bf16*)(ws + WS_WDN) + (size_t)l * DM * DFF, MAP_ID, scr, r % I_DN, lane); continue; } r -= 4 * I_DN;
        if (r < 2 * I_AIN) { const int l = r / I_AIN; tr_item(a.in[1] + (size_t)l * DM * ATT_IN, DM, ATT_IN, ATT_N, (bf16*)(ws + WS_WAIN) + (size_t)l * ATT_N * DM, MAP_ATT, scr, r % I_AIN, lane); continue; } r -= 2 * I_AIN;
        if (r < 2 * I_MIN) { const int l = r / I_MIN; tr_item(a.in[5] + (size_t)l * DM * ML_IN, DM, ML_IN, ML_N, (bf16*)(ws + WS_WMIN) + (size_t)l * ML_N * DM, MAP_ID, scr, r % I_MIN, lane); continue; } r -= 2 * I_MIN;
        if (r < 2 * I_OUT) { const int l = r / I_OUT; tr_item(a.in[4] + (size_t)l * DM * DM, DM, DM, DM, (bf16*)(ws + WS_WAOUT) + (size_t)l * DM * DM, MAP_ID, scr, r % I_OUT, lane); continue; } r -= 2 * I_OUT;
        if (r < 2 * I_OUT) { const int l = r / I_OUT; tr_item(a.in[7] + (size_t)l * DM * DM, DM, DM, DM, (bf16*)(ws + WS_WMOUT) + (size_t)l * DM * DM, MAP_ID, scr, r % I_OUT, lane); continue; } r -= 2 * I_OUT;
        if (r < 2 * I_G) { const int l = r / I_G; tr_item(a.in[1] + (size_t)l * DM * ATT_IN, DM, ATT_IN, 32, (bf16*)(ws + WS_WG) + (size_t)l * 32 * DM, MAP_ATTG, scr, r % I_G, lane); continue; } r -= 2 * I_G;
        { const int l = r / I_G; tr_item(a.in[5] + (size_t)l * DM * ML_IN, DM, ML_IN, 32, (bf16*)(ws + WS_WG) + (size_t)(2 + l) * 32 * DM, MAP_MLG, scr, r % I_G, lane); }
    }
    { const float* x = a.in[0]; float* X = (float*)(ws + WS_X); bf16* XB = (bf16*)(ws + WS_XB);
      for (int m = gw; m < MTOK; m += NGW) {
          const GAS f32x4* xr = (const GAS f32x4*)(x + (size_t)m * DM) + lane; GAS f32x4* o = (GAS f32x4*)(X + (size_t)m * DM) + lane; GAS v2u* ob = (GAS v2u*)(XB + (size_t)m * DM) + lane;
#pragma unroll
          for (int j = 0; j < 8; ++j) { const f32x4 v = xr[64 * j]; o[64 * j] = v; v2u w; w.x = pk2(v.x, v.y); w.y = pk2(v.z, v.w); ob[64 * j] = w; } } }
    const int gt = (vcu * NTHREADS) + tid, NGT = G * NTHREADS;
    { float* rope = (float*)(ws + WS_ROPE);
      for (int i = gt; i < 4096 * 64; i += NGT) { const int pos = i >> 6, f = i & 63;
          const float inv = powf(10000.0f, -(float)f * (2.0f / 128.0f)); const float ang = (float)pos * inv;
          double ad = (double)ang; ad -= 6.283185307179586476925 * rint(ad * 0.15915494309189533577);
          const float ar = (float)ad; rope[2 * i] = cosf(ar); rope[2 * i + 1] = sinf(ar); } }
    { float* bA = (float*)(ws + WS_BIASA);
      for (int i = gt; i < 2 * ATT_N; i += NGT) { const int l = i / ATT_N, n = i % ATT_N; bA[i] = a.in[2][(size_t)l * ATT_IN + src_col(MAP_ATT, n)]; } }
    { float* cw = (float*)(ws + WS_CONVW); float* cb = (float*)(ws + WS_CONVB);
      for (int i = gt; i < 4 * 3 * UPN; i += NGT) { const int lj = i / UPN, n = i % UPN; cw[i] = a.in[9][(size_t)lj * UPN + src_col(MAP_UP, n)]; }
      for (int i = gt; i < 4 * UPN; i += NGT) { const int l = i / UPN, n = i % UPN; cb[i] = a.in[10][(size_t)l * UPN + src_col(MAP_UP, n)]; } }
}

__device__ __forceinline__ void gates_phase(const bf16* XB, const bf16* WG, const float* bsrc, int nb, float* GATES, int gw, int NGW, int lane) {
    typedef float f4 __attribute__((ext_vector_type(4)));
    for (int task = gw; task < MTOK / 16; task += NGW) {
        const int m0 = task * 16;
        f4 acc = (f4){0.f, 0.f, 0.f, 0.f};
        const bf16* ap = XB + (size_t)(m0 + (lane & 15)) * DM + 8 * (lane >> 4);
        const bf16* bp = WG + (size_t)(lane & 15) * DM + 8 * (lane >> 4);
#pragma unroll 8
        for (int k0 = 0; k0 < DM; k0 += 32) { const bf16x8 av = *(const bf16x8*)(ap + k0); const bf16x8 bv = *(const bf16x8*)(bp + k0); acc = __builtin_amdgcn_mfma_f32_16x16x32_bf16(av, bv, acc, 0, 0, 0); }
        const int g = lane & 15; const float bias = g < nb ? bsrc[g] : 0.f;
#pragma unroll
        for (int r = 0; r < 4; ++r) GATES[(size_t)(m0 + (lane >> 4) * 4 + r) * 16 + g] = acc[r] + bias;
    }
}

__device__ __forceinline__ void ln_phase(const float* X, float* Xo, bf16* XBo, const float* g, const float* b, int gw, int NGW, int lane) {
    f32x4 gv[8], bv[8];
#pragma unroll
    for (int j = 0; j < 8; ++j) { gv[j] = ((const f32x4*)g)[lane + 64 * j]; bv[j] = ((const f32x4*)b)[lane + 64 * j]; }
    for (int m = gw; m < MTOK; m += NGW) {
        const GAS f32x4* xr = (const GAS f32x4*)(X + (size_t)m * DM) + lane;
        f32x4 v[8]; float s = 0.f;
#pragma unroll
        for (int j = 0; j < 8; ++j) { v[j] = xr[64 * j]; s += (v[j].x + v[j].y) + (v[j].z + v[j].w); }
        const float mean = wave_sum_l(s, lane) * (1.f / DM); float s2 = 0.f;
#pragma unroll
        for (int j = 0; j < 8; ++j) { v[j] = v[j] - mean; s2 += (v[j].x * v[j].x + v[j].y * v[j].y) + (v[j].z * v[j].z + v[j].w * v[j].w); }
        const float rstd = 1.f / sqrtf(wave_sum_l(s2, lane) * (1.f / DM) + LN_EPS);
        GAS f32x4* o = (GAS f32x4*)(Xo + (size_t)m * DM) + lane;
#pragma unroll
        for (int j = 0; j < 8; ++j) { v[j] = v[j] * rstd * gv[j] + bv[j]; o[64 * j] = v[j]; }
        if (XBo) { GAS v2u* ob = (GAS v2u*)(XBo + (size_t)m * DM) + lane;
#pragma unroll
            for (int j = 0; j < 8; ++j) { v2u w; w.x = pk2(v[j].x, v[j].y); w.y = pk2(v[j].z, v[j].w); ob[64 * j] = w; } }
    }
}

__device__ __forceinline__ void conv_phase(const bf16* U, bf16* H, const float* cw  , const float* cb  , int gt, int NGT) {
    constexpr int RS = 16, NSTRIP = MTOK / RS, NCG = (UPN / 256) * 16;
    for (int it = gt; it < NSTRIP * NCG; it += NGT) {
        const int strip = it / NCG, cg = it % NCG, tile = cg >> 4, g8 = cg & 15;
        const int pc = tile * 256 + g8 * 8;
        const int t0 = strip * RS;
        float wg[3][8], wv[3][8], bg[8], bvv[8];
#pragma unroll
        for (int j = 0; j < 3; ++j) { const f32x4 a0 = *(const f32x4*)(cw + (size_t)j * UPN + pc), a1 = *(const f32x4*)(cw + (size_t)j * UPN + pc + 4), c0 = *(const f32x4*)(cw + (size_t)j * UPN + pc + 128), c1 = *(const f32x4*)(cw + (size_t)j * UPN + pc + 132);
#pragma unroll
            for (int e = 0; e < 4; ++e) { wg[j][e] = a0[e]; wg[j][4 + e] = a1[e]; wv[j][e] = c0[e]; wv[j][4 + e] = c1[e]; } }
        { const f32x4 a0 = *(const f32x4*)(cb + pc), a1 = *(const f32x4*)(cb + pc + 4), c0 = *(const f32x4*)(cb + pc + 128), c1 = *(const f32x4*)(cb + pc + 132);
#pragma unroll
          for (int e = 0; e < 4; ++e) { bg[e] = a0[e]; bg[4 + e] = a1[e]; bvv[e] = c0[e]; bvv[4 + e] = c1[e]; } }
        float g2[8], g1[8], v2[8], v1[8];
        const bool first = (t0 & (SEQ - 1)) == 0;
#pragma unroll
        for (int e = 0; e < 8; ++e) { g2[e] = 0.f; g1[e] = 0.f; v2[e] = 0.f; v1[e] = 0.f; }
        if (!first) {
            const v4u a = *(const v4u*)(U + (size_t)(t0 - 2) * UPN + pc), b = *(const v4u*)(U + (size_t)(t0 - 1) * UPN + pc), c = *(const v4u*)(U + (size_t)(t0 - 2) * UPN + pc + 128), d = *(const v4u*)(U + (size_t)(t0 - 1) * UPN + pc + 128);
#pragma unroll
            for (int e = 0; e < 4; ++e) { g2[2 * e] = bflo(a[e]); g2[2 * e + 1] = bfhi(a[e]); g1[2 * e] = bflo(b[e]); g1[2 * e + 1] = bfhi(b[e]);
                                          v2[2 * e] = bflo(c[e]); v2[2 * e + 1] = bfhi(c[e]); v1[2 * e] = bflo(d[e]); v1[2 * e + 1] = bfhi(d[e]); }
        }
#pragma unroll 4
        for (int r = 0; r < RS; ++r) {
            const int t = t0 + r;
            const v4u a = *(const v4u*)(U + (size_t)t * UPN + pc), c = *(const v4u*)(U + (size_t)t * UPN + pc + 128);
            float g0[8], v0[8], o[8];
#pragma unroll
            for (int e = 0; e < 4; ++e) { g0[2 * e] = bflo(a[e]); g0[2 * e + 1] = bfhi(a[e]); v0[2 * e] = bflo(c[e]); v0[2 * e + 1] = bfhi(c[e]); }
#pragma unroll
            for (int e = 0; e < 8; ++e) {
                const float cgt = bg[e] + wg[0][e] * g2[e] + wg[1][e] * g1[e] + wg[2][e] * g0[e];
                const float cvl = bvv[e] + wv[0][e] * v2[e] + wv[1][e] * v1[e] + wv[2][e] * v0[e];
                o[e] = cgt / (1.f + __expf(-cgt)) * cvl;
                g2[e] = g1[e]; g1[e] = g0[e]; v2[e] = v1[e]; v1[e] = v0[e];
            }
            v4u w; w.x = pk2(o[0], o[1]); w.y = pk2(o[2], o[3]); w.z = pk2(o[4], o[5]); w.w = pk2(o[6], o[7]);
            *(v4u*)(H + (size_t)t * DFF + tile * 128 + g8 * 8) = w;
        }
    }
}


__device__ __forceinline__ void conv_fix_phase(const float* halo, const float* raw0, bf16* H, const float* cw, const float* cb, int gt, int NGT) {
    constexpr int NFG = DFF / 4;
    for (int it = gt; it < (MTOK / 256) * 2 * NFG; it += NGT) {
        const int pm = it / (2 * NFG), rem = it % (2 * NFG), row = rem / NFG, f = (rem % NFG) * 4;
        if ((pm & 15) == 0) continue;
        const int pc = (f >> 7) * 256 + (f & 127);
        f32x4 c[2];
#pragma unroll
        for (int bj = 0; bj < 2; ++bj) { const int col = pc + 128 * bj;
            const f32x4 h0 = *(const f32x4*)(halo + ((size_t)(pm - 1) * 2 + 0) * UPN + col), h1 = *(const f32x4*)(halo + ((size_t)(pm - 1) * 2 + 1) * UPN + col);
            const f32x4 r0 = *(const f32x4*)(raw0 + ((size_t)pm * 2 + 0) * UPN + col), r1 = *(const f32x4*)(raw0 + ((size_t)pm * 2 + 1) * UPN + col);
            const f32x4 u2 = row == 0 ? h0 : h1, u1 = row == 0 ? h1 : r0, u0 = row == 0 ? r0 : r1;
            c[bj] = *(const f32x4*)(cb + col) + *(const f32x4*)(cw + col) * u2 + *(const f32x4*)(cw + UPN + col) * u1 + *(const f32x4*)(cw + 2 * (size_t)UPN + col) * u0; }
        v2u o; float h[4];
#pragma unroll
        for (int i = 0; i < 4; ++i) h[i] = c[0][i] / (1.f + __expf(-c[0][i])) * c[1][i];
        o.x = pk2(h[0], h[1]); o.y = pk2(h[2], h[3]);
        *(v2u*)(H + (size_t)(pm * 256 + row) * DFF + f) = o;
    }
}

namespace att {
constexpr float SCALE = 0.08838834764831845f, LOG2E = 1.4426950408889634f, C2 = LOG2E * SCALE, THR2 = 8.f * LOG2E;
constexpr int NW = 8, QBLK = 32, KVBLK = 64, QB = NW * QBLK, D = 128;
constexpr int SHM_V = KVBLK * D * 2, SHM_K = KVBLK * D * 2;
constexpr int WS_OFF = 2 * SHM_V + 2 * SHM_K, C2_OFF = WS_OFF + NW * 64 * 4, LDS_NEED = C2_OFF + SEQ * 4;
constexpr int KS = ATT_N, OS = DM;
typedef float f32x16 __attribute__((ext_vector_type(16)));
typedef unsigned u32x4 __attribute__((ext_vector_type(4)));

#define KSWZ(row, colB) ((row) * 256 + ((colB) ^ (((row) & 7) << 4)))
#define SBAR() __builtin_amdgcn_sched_barrier(0)
__device__ __forceinline__ int v_st(int k, int c) { const int kk = (k & ~0xC) | ((k & 4) << 1) | ((k & 8) >> 1); return ((kk >> 3) * 4 + (c >> 5)) * 512 + ((kk & 7) * 32 + (c & 31)) * 2; }
__device__ __forceinline__ int v_rd_base(int lane) { return ((lane & 3) << 3) | (((lane >> 2) & 3) << 6) | (((lane >> 4) & 1) << 5) | (((lane >> 5) & 1) << 8); }
constexpr int v_rd_off(int d0, int ks, int half) { return d0 * 512 + ks * 4096 + half * 2048; }
__device__ __forceinline__ int crow(int r, int hi) { return (r & 3) + 8 * (r >> 2) + 4 * hi; }
__device__ __forceinline__ unsigned cvtpk(float lo, float hi) { unsigned r; asm volatile("v_cvt_pk_bf16_f32 %0, %1, %2" : "=v"(r) : "v"(lo), "v"(hi)); return r; }
__device__ __forceinline__ bf16x8 load8(const bf16* p) { return *reinterpret_cast<const bf16x8*>(p); }
__device__ __forceinline__ void mask_tile(f32x16& p0, f32x16& p1, int dq, unsigned W) {
    const float NEG = -__builtin_inff();
#pragma unroll
    for (int r = 0; r < 16; ++r) {
        const int c = (r & 3) + 8 * (r >> 2);
        if ((unsigned)(dq - c) >= W) p0[r] = NEG;
        if ((unsigned)(dq - c - 32) >= W) p1[r] = NEG;
    }
}
template <int MODE>
__device__ __forceinline__ void partialSM(f32x16& p0, f32x16& p1, float& m_reg, float& mn, float& alpha, const LAS float* c2k  , float ct2) {
    if constexpr (MODE == 0) {
#pragma unroll
        for (int g = 0; g < 4; ++g) { const f32x4 b0 = *(const LAS f32x4*)(c2k + 8 * g), b1 = *(const LAS f32x4*)(c2k + 32 + 8 * g);
#pragma unroll
            for (int e = 0; e < 4; ++e) { p0[4 * g + e] = fmaf(p0[4 * g + e], C2, ct2 - b0[e]); p1[4 * g + e] = fmaf(p1[4 * g + e], C2, ct2 - b1[e]); } }
    } else {
#pragma unroll
        for (int r = 0; r < 16; ++r) { p0[r] *= C2; p1[r] *= C2; }
    }
    float pmax = p0[0];
#pragma unroll
    for (int r = 1; r < 16; ++r) pmax = fmaxf(pmax, p0[r]);
#pragma unroll
    for (int r = 0; r < 16; ++r) pmax = fmaxf(pmax, p1[r]);
    { auto rr = __builtin_amdgcn_permlane32_swap(__float_as_uint(pmax), __float_as_uint(pmax), false, false);
      pmax = fmaxf(__uint_as_float(rr[0]), __uint_as_float(rr[1])); }
    if (__builtin_expect(__all((pmax - m_reg) <= THR2), 1)) { mn = m_reg; alpha = 1.f; }
    else { mn = fmaxf(m_reg, pmax); alpha = __builtin_amdgcn_exp2f(m_reg - mn); m_reg = mn; }
#pragma unroll
    for (int r = 0; r < 16; ++r) { p0[r] -= mn; p1[r] -= mn; }
#pragma unroll
    for (int r = 0; r < 16; ++r) p0[r] = __builtin_amdgcn_exp2f(p0[r]);
}
__device__ __forceinline__ void finishSM(f32x16& p0, f32x16& p1, float alpha, float& l_reg, bf16x8& pa0, bf16x8& pa1, bf16x8& pa2, bf16x8& pa3) {
#pragma unroll
    for (int r = 0; r < 16; ++r) p1[r] = __builtin_amdgcn_exp2f(p1[r]);
    float ps = 0;
#pragma unroll
    for (int r = 0; r < 16; ++r) ps += p0[r];
#pragma unroll
    for (int r = 0; r < 16; ++r) ps += p1[r];
    { auto rr = __builtin_amdgcn_permlane32_swap(__float_as_uint(ps), __float_as_uint(ps), false, false);
      ps = __uint_as_float(rr[0]) + __uint_as_float(rr[1]); }
    l_reg = l_reg * alpha + ps;
#define PK4(P, B_, OUT) do { unsigned a0 = cvtpk(P[B_+0], P[B_+1]), a1 = cvtpk(P[B_+2], P[B_+3]);                          \
        unsigned b0 = cvtpk(P[B_+4], P[B_+5]), b1 = cvtpk(P[B_+6], P[B_+7]);                                             \
        auto r0 = __builtin_amdgcn_permlane32_swap(a0, b0, false, false); auto r1 = __builtin_amdgcn_permlane32_swap(a1, b1, false, false); \
        u32x4 w = {r0[0], r1[0], r0[1], r1[1]}; OUT = *reinterpret_cast<bf16x8*>(&w); } while (0)
    PK4(p0, 0, pa0); PK4(p0, 8, pa1); PK4(p1, 0, pa2); PK4(p1, 8, pa3);
#undef PK4
}
template <int KB, bool SK>
__device__ __forceinline__ void qkt(f32x16& p0, f32x16& p1, const char* K_lds, int r32, int hi, const bf16x8* qr, bool act) {
    if (SK && !act) { const float NEG = -__builtin_inff();
#pragma unroll
        for (int r = 0; r < 16; ++r) { p0[r] = NEG; p1[r] = NEG; } return; }
    p0 = f32x16{}; p1 = f32x16{};
    const char* kb[4];
#pragma unroll
    for (int dd = 0; dd < 4; ++dd) kb[dd] = K_lds + KB * SHM_K + KSWZ(r32, (dd * 16 + hi * 8) * 2);
#pragma unroll
    for (int d0 = 0; d0 < 8; ++d0) { const char* a = kb[d0 & 3] + (d0 >> 2) * 128;
        bf16x8 b0 = *reinterpret_cast<const bf16x8*>(a);
        bf16x8 b1 = *reinterpret_cast<const bf16x8*>(a + 32 * 256);
        p0 = __builtin_amdgcn_mfma_f32_32x32x16_bf16(b0, qr[d0], p0, 0, 0, 0);
        p1 = __builtin_amdgcn_mfma_f32_32x32x16_bf16(b1, qr[d0], p1, 0, 0, 0); }
}
template <int VB, bool SK>
__device__ __forceinline__ void pv_tile(f32x16* o, int vb0, bf16x8 pa0, bf16x8 pa1, bf16x8 pa2, bf16x8 pa3, bool act) {
    if (SK && !act) return;
#define TRRD(dst, off) asm volatile("ds_read_b64_tr_b16 %0, %1 offset:%2" : "=&v"(dst) : "v"(vb0), "i"(off) : "memory")
#define PV_D0(d0) do { s16x4 l0, l1, l2, l3, h0, h1, h2, h3; constexpr int b_ = VB * SHM_V + v_rd_off(d0, 0, 0); \
        TRRD(l0, b_); TRRD(h0, b_ + 2048); TRRD(l1, b_ + 4096); TRRD(h1, b_ + 6144); TRRD(l2, b_ + 8192); TRRD(h2, b_ + 10240); TRRD(l3, b_ + 12288); TRRD(h3, b_ + 14336); \
        asm volatile("s_waitcnt lgkmcnt(0)" ::: "memory"); SBAR();   \
        o[d0] = __builtin_amdgcn_mfma_f32_32x32x16_bf16(pa0, (bf16x8){l0[0], l0[1], l0[2], l0[3], h0[0], h0[1], h0[2], h0[3]}, o[d0], 0, 0, 0);   \
        o[d0] = __builtin_amdgcn_mfma_f32_32x32x16_bf16(pa1, (bf16x8){l1[0], l1[1], l1[2], l1[3], h1[0], h1[1], h1[2], h1[3]}, o[d0], 0, 0, 0);   \
        o[d0] = __builtin_amdgcn_mfma_f32_32x32x16_bf16(pa2, (bf16x8){l2[0], l2[1], l2[2], l2[3], h2[0], h2[1], h2[2], h2[3]}, o[d0], 0, 0, 0);   \
        o[d0] = __builtin_amdgcn_mfma_f32_32x32x16_bf16(pa3, (bf16x8){l3[0], l3[1], l3[2], l3[3], h3[0], h3[1], h3[2], h3[3]}, o[d0], 0, 0, 0); } while (0)
    PV_D0(0); PV_D0(1); PV_D0(2); PV_D0(3);
#undef PV_D0
#undef TRRD
}

struct BlockRef { const bf16* Q; const bf16* K; const bf16* V; bf16* O; int P0; float m0; };
struct Seam { bf16x8 qr[8]; bf16x8 st_v0, st_v1, st_k0, st_k1; };
__device__ __forceinline__ int swa_jlo(int P0, int W) { const int lowk = P0 - W + 1; return lowk > 0 ? lowk / KVBLK : 0; }
#define ROW(p, k0, rr) ((p) + (size_t)((k0) + (rr)) * KS + sc)
#define VMW() asm volatile("s_waitcnt vmcnt(0)" ::: "memory")
#define VMWN(n) asm volatile("s_waitcnt vmcnt(%0)" :: "i"(n) : "memory")
#define SLOAD_H(Kp, Vp, k0) do { S.st_v0 = load8(ROW(Vp, k0, sr)); S.st_v1 = load8(ROW(Vp, k0, 32 + sr));              \
                         S.st_k0 = load8(ROW(Kp, k0, sr)); S.st_k1 = load8(ROW(Kp, k0, 32 + sr)); } while (0)
#define SWRITE_HK(bf) do { *(bf16x8*)(K_lds + (bf) * SHM_K + kws) = S.st_k0; *(bf16x8*)(K_lds + (bf) * SHM_K + kws + 32 * 256) = S.st_k1; } while (0)
#define SWRITE_HV(bf) do { *(bf16x8*)(V_lds + (bf) * SHM_V + vst0) = S.st_v0; *(bf16x8*)(V_lds + (bf) * SHM_V + vst1) = S.st_v1; } while (0)
#define SWRITE_H(bf) do { SWRITE_HV(bf); SWRITE_HK(bf); } while (0)
template <int W>
__device__ __forceinline__ void prime(const BlockRef& cur, char* lds, Seam& S) {
    int tid_l = threadIdx.x; asm volatile("" : "+v"(tid_l));
    const int tid = tid_l, wid = __builtin_amdgcn_readfirstlane(tid >> 6), lane = tid & 63, r32 = lane & 31, hi = lane >> 5;
    const int sr = tid >> 4, sc = (tid & 15) * 8, kws = KSWZ(sr, sc * 2); char* K_lds = lds + 2 * SHM_V;
    const int kb0 = swa_jlo(cur.P0, W) * KVBLK;
#pragma unroll
    for (int d0 = 0; d0 < 8; ++d0) S.qr[d0] = load8(cur.Q + (size_t)(wid * QBLK + r32) * KS + d0 * 16 + hi * 8);
    SLOAD_H(cur.K, cur.V, kb0); VMW(); SWRITE_HK(0);
    __syncthreads();
}
template <int MODE, int W, bool SK>
__device__ __forceinline__ void block(const BlockRef& cur, const BlockRef& nxt, char* lds, Seam& S) {
    int tid_l = threadIdx.x; asm volatile("" : "+v"(tid_l));
    const int tid = tid_l, wid = __builtin_amdgcn_readfirstlane(tid >> 6), lane = tid & 63, r32 = lane & 31, hi = lane >> 5;
    const int j_lo = swa_jlo(cur.P0, W);
    const int j_hi = (cur.P0 + QB - 1) / KVBLK + 1;
    const int NT = j_hi - j_lo;
    const int kbn = swa_jlo(nxt.P0, W) * KVBLK;
    const int qlo = cur.P0 + wid * QBLK, qm = qlo + r32 - 4 * hi;
    char* V_lds = lds; char* K_lds = lds + 2 * SHM_V;
    float* ws = (float*)(lds + WS_OFF) + wid * 64; float* li_l = ws, * al_l = ws + 32;
    const LAS float* c2 = (const LAS float*)((LAS unsigned char*)lds + C2_OFF);
    const float ct2 = (MODE == 0) ? c2[qlo + r32] : 0.f;
    float m_reg = (MODE == 0) ? -1e30f : cur.m0, l_reg = (MODE == 0) ? 0.f : 1.f; f32x16 o[4] = {};
    const int sr = tid >> 4, sc = (tid & 15) * 8, vst0 = v_st(sr, sc), vst1 = v_st(32 + sr, sc), kws = KSWZ(sr, sc * 2);
    const int vb0 = (int)(uintptr_t)V_lds + v_rd_base(lane);
    const bf16* Kh = cur.K; const bf16* Vh = cur.V;
#define RESC(a) do { if (__any((a) < 1.f)) { if (hi == 0) al_l[r32] = (a); asm volatile("s_waitcnt lgkmcnt(0)" ::: "memory");              \
                     for (int d_ = 0; d_ < 4; ++d_) for (int r = 0; r < 16; ++r) o[d_][r] *= al_l[crow(r, hi)]; } } while (0)
#define KBASE(t) ((j_lo + (t)) * KVBLK)
#define ACT(t) (KBASE(t) <= qlo + QBLK - 1 && KBASE(t) + KVBLK - 1 >= qlo - W + 1)
#define MASKT(P0_, P1_, t) do { const int kb_ = KBASE(t); if ((!SK || ACT(t)) && (kb_ + KVBLK - 1 > qlo || kb_ <= qlo + QBLK - 1 - W)) mask_tile(P0_, P1_, qm - kb_, (unsigned)W); } while (0)
#define PSM(PX0, PX1, mnX, alX, t) partialSM<MODE>(PX0, PX1, m_reg, mnX, alX, c2 + KBASE(t) + 4 * hi, ct2)
    constexpr int NQL = 8;
#define SEAM_K0() do { VMWN(NQL); SWRITE_HK(0); SBAR(); } while (0)
    f32x16 pA0, pA1, pB0, pB1; float mnA, mnB, alA, alB; bf16x8 pa0, pa1, pa2, pa3;
    SWRITE_HV(0); SBAR();
    if (NT > 1) { SLOAD_H(Kh, Vh, KBASE(1)); }
    SBAR(); qkt<0, SK>(pA0, pA1, K_lds, r32, hi, S.qr, ACT(0));
    MASKT(pA0, pA1, 0); PSM(pA0, pA1, mnA, alA, 0);
    if (NT > 1) { VMW(); SWRITE_H(1); }
    __syncthreads();
#define HALF_STEP(PX0, PX1, mnX, alX, PY0, PY1, alY, t, KB, VB, SB) do {                                                      \
        SBAR(); qkt<KB, SK>(PX0, PX1, K_lds, r32, hi, S.qr, ACT(t));                                             \
        finishSM(PY0, PY1, alY, l_reg, pa0, pa1, pa2, pa3); SBAR();                                                           \
        if ((t) + 1 < NT) { SLOAD_H(Kh, Vh, KBASE((t) + 1)); SBAR(); }                                               \
        pv_tile<VB, SK>(o, vb0, pa0, pa1, pa2, pa3, ACT((t) - 1)); MASKT(PX0, PX1, (t)); PSM(PX0, PX1, mnX, alX, (t));                                        \
        __syncthreads();                                                                                                      \
        if ((t) + 1 < NT) { VMW(); SWRITE_H(SB); }                                                                          \
        RESC(alX); __syncthreads(); } while (0)
    for (int t = 1; t + 1 < NT; t += 2) {
        HALF_STEP(pB0, pB1, mnB, alB, pA0, pA1, alA, t, 1, 0, 0);
        HALF_STEP(pA0, pA1, mnA, alA, pB0, pB1, alB, t + 1, 0, 1, 1);
    }
    const bool even = (NT & 1) == 0;
    if (even) { SBAR(); qkt<1, SK>(pB0, pB1, K_lds, r32, hi, S.qr, ACT(NT - 1)); SBAR(); }
    SLOAD_H(nxt.K, nxt.V, kbn); SBAR();
#pragma unroll
    for (int d0 = 0; d0 < 8; ++d0) S.qr[d0] = load8(nxt.Q + (size_t)(wid * QBLK + r32) * KS + d0 * 16 + hi * 8);
    SBAR();
    finishSM(pA0, pA1, alA, l_reg, pa0, pa1, pa2, pa3); SBAR();
    pv_tile<0, SK>(o, vb0, pa0, pa1, pa2, pa3, ACT(even ? NT - 2 : NT - 1));
    if (even) { MASKT(pB0, pB1, NT - 1); PSM(pB0, pB1, mnB, alB, NT - 1); __syncthreads(); RESC(alB);
        finishSM(pB0, pB1, alB, l_reg, pa0, pa1, pa2, pa3); SBAR(); pv_tile<1, SK>(o, vb0, pa0, pa1, pa2, pa3, ACT(NT - 1)); }
    SBAR(); SEAM_K0();
    if (hi == 0) li_l[r32] = l_reg; asm volatile("s_waitcnt lgkmcnt(0)" ::: "memory");
    float rli[16];
#pragma unroll
    for (int r = 0; r < 16; ++r) rli[r] = __builtin_amdgcn_rcpf(li_l[crow(r, hi)]);
    bf16* Ow = cur.O + (size_t)(wid * QBLK) * OS;
#pragma unroll
    for (int r = 0; r < 16; ++r) { const int orow = crow(r, hi);
#pragma unroll
        for (int d0 = 0; d0 < 4; ++d0) { const float v = o[d0][r] * rli[r];
            const float vn = shfl_idx(v, lane ^ 1);
            if ((r32 & 1) == 0) *(unsigned*)(Ow + (size_t)orow * OS + d0 * 32 + r32) = cvtpk(v, vn); } }
    __syncthreads();
#undef RESC
#undef KBASE
#undef ACT
#undef MASKT
#undef PSM
#undef SEAM_K0
#undef HALF_STEP
}
#undef ROW
#undef VMW
#undef VMWN
#undef SLOAD_H
#undef SWRITE_HK
#undef SWRITE_HV
#undef SWRITE_H

__device__ __forceinline__ void fox_ctable(const float* GATES, int b, int h, char* lds) {
    LAS float* c2 = (LAS float*)((LAS unsigned char*)lds + C2_OFF);
    LAS float* wsum = (LAS float*)((LAS unsigned char*)lds + WS_OFF);
    int tid_l = threadIdx.x; asm volatile("" : "+v"(tid_l));
    const int tid = tid_l, lane = tid & 63, wid = tid >> 6;
    float v[8]; float s = 0.f;
#pragma unroll
    for (int e = 0; e < 8; ++e) { v[e] = log_sigmoid(GATES[(size_t)(b * SEQ + tid * 8 + e) * 16 + h]) * LOG2E; s += v[e]; v[e] = s; }
    float inc = s;
#pragma unroll
    for (int o = 1; o < 64; o <<= 1) { const float t = shfl_idx(inc, lane - o); if (lane >= o) inc += t; }
    if (lane == 63) wsum[wid] = inc;
    __syncthreads();
    float base = inc - s;
    for (int w = 0; w < wid; ++w) base += wsum[w];
#pragma unroll
    for (int e = 0; e < 8; ++e) c2[tid * 8 + e] = base + v[e];
    __syncthreads();
}

__device__ __forceinline__ void attn_phase(const bf16* PROJ, const float* GATES, const float* sinks, bf16* HEADS, char* lds, int bx, int G) {
    constexpr int NQB = SEQ / QB;
    for (int L = bx; L < NBATCH * FOXH * (NQB / 2); L += G) {
        const int bh = L / (NQB / 2), x = L % (NQB / 2), b = bh / FOXH, h = bh % FOXH;
        fox_ctable(GATES, b, h, lds);
        const bf16* base = PROJ + (size_t)b * SEQ * KS;
        BlockRef r0, r1;
        r0.Q = base + (size_t)(x * QB) * KS + A_FQ + h * 128; r0.K = base + A_FK + h * 128; r0.V = base + A_FV + h * 128; r0.O = HEADS + ((size_t)b * SEQ + x * QB) * OS + h * 128; r0.P0 = x * QB; r0.m0 = 0.f;
        const int y = NQB - 1 - x;
        r1 = r0; r1.Q = base + (size_t)(y * QB) * KS + A_FQ + h * 128; r1.O = HEADS + ((size_t)b * SEQ + y * QB) * OS + h * 128; r1.P0 = y * QB;
        Seam S;
        prime<SEQ>(r0, lds, S);
        BlockRef cur = r0, nxt = r1;
        for (int pass = 0; pass < 2; ++pass) { block<0, SEQ, false>(cur, nxt, lds, S); cur = nxt; }
    }
    for (int L = bx; L < NBATCH * SWAQ * (NQB / 2); L += G) {
        const int bh = L / (NQB / 2), x = L % (NQB / 2), b = bh / SWAQ, h = bh % SWAQ, kvh = h / (SWAQ / SWAKV);
        const bf16* base = PROJ + (size_t)b * SEQ * KS;
        BlockRef r0, r1;
        r0.Q = base + (size_t)(2 * x * QB) * KS + A_SQ + h * 128; r0.K = base + A_SK + kvh * 128; r0.V = base + A_SV + kvh * 128; r0.O = HEADS + ((size_t)b * SEQ + 2 * x * QB) * OS + 1024 + h * 128; r0.P0 = 2 * x * QB;
        r0.m0 = sinks[h] * LOG2E;
        r1 = r0; r1.Q = r0.Q + (size_t)QB * KS; r1.O = r0.O + (size_t)QB * OS; r1.P0 = r0.P0 + QB;
        Seam S;
        prime<SWAW>(r0, lds, S);
        BlockRef cur = r0, nxt = r1;
        for (int pass = 0; pass < 2; ++pass) { block<1, SWAW, true>(cur, nxt, lds, S); cur = nxt; }
    }
}
#undef KSWZ
#undef SBAR
}

namespace mls {
constexpr float SCALE = 0.08838834764831845f, LOG2E = 1.4426950408889634f;
constexpr int RS = 272, RSV = 144;
constexpr int QT = 0, KT = 17408, VT = 34816, VW = 44032, CB = 53248;
constexpr int A2O = 71680, M2O = A2O + 16384, NBO = M2O + 16384, MCO = NBO + 16384, BLO = MCO + 256, AMO = BLO + 256, LDS_NEED = AMO + 256;
static_assert(LDS_NEED <= 131072, "mlstm LDS");
typedef float f32x16 __attribute__((ext_vector_type(16)));
typedef unsigned u32x4 __attribute__((ext_vector_type(4)));
__device__ __forceinline__ unsigned cvtpk(float lo, float hi) { unsigned r; asm volatile("v_cvt_pk_bf16_f32 %0, %1, %2" : "=v"(r) : "v"(lo), "v"(hi)); return r; }
__device__ __forceinline__ int crow(int r, int hi) { return (r & 3) + 8 * (r >> 2) + 4 * hi; }
#define MLS_TR(dst, addr, off) asm volatile("ds_read_b64_tr_b16 %0, %1 offset:%2" : "=&v"(dst) : "v"(addr), "i"(off) : "memory")
#define MLS_PK4(P, B_, OUT) do { unsigned a0 = cvtpk(P[B_+0], P[B_+1]), a1 = cvtpk(P[B_+2], P[B_+3]);                          \
        unsigned b0 = cvtpk(P[B_+4], P[B_+5]), b1 = cvtpk(P[B_+6], P[B_+7]);                                             \
        auto r0 = __builtin_amdgcn_permlane32_swap(a0, b0, false, false); auto r1 = __builtin_amdgcn_permlane32_swap(a1, b1, false, false); \
        u32x4 w = {r0[0], r1[0], r0[1], r1[1]}; OUT = *reinterpret_cast<bf16x8*>(&w); } while (0)

__device__ __forceinline__ void mlstm_unit(const bf16* PROJ, const float* GATES, bf16* HEADS, LAS unsigned char* lds, int b, int h, int vs) {
    int tid_l = threadIdx.x; asm volatile("" : "+v"(tid_l));
    const int tid = tid_l, lane = tid & 63, wid = __builtin_amdgcn_readfirstlane(tid >> 6), r = lane & 31, hh = lane >> 5;
    LAS float* A2 = (LAS float*)(lds + A2O); LAS float* M2 = (LAS float*)(lds + M2O); LAS float* NB = (LAS float*)(lds + NBO);
    LAS float* MC = (LAS float*)(lds + MCO); LAS float* BL = (LAS float*)(lds + BLO); LAS float* AM = (LAS float*)(lds + AMO);
    const float NEG = -__builtin_inff();
    unsigned zl = 0u; asm volatile("" : "+v"(zl));
    for (int i = tid; i < (CB + 64 * RS - VT) / 16; i += NTHREADS) *(LAS v4u*)(lds + VT + i * 16) = (v4u){zl, zl, zl, zl};
    {
        float ip[8], lf[8];
#pragma unroll
        for (int e = 0; e < 8; ++e) { const size_t row = (size_t)(b * SEQ + tid * 8 + e); ip[e] = GATES[row * 16 + h]; lf[e] = log_sigmoid(GATES[row * 16 + 8 + h]); }
        float run = 0.f;
#pragma unroll
        for (int e = 0; e < 8; ++e) { run += lf[e]; lf[e] = run; }
        float inc = run;
#pragma unroll
        for (int o = 1; o < 8; o <<= 1) { const float t = shfl_idx(inc, lane - o); if ((lane & 7) >= o) inc += t; }
        const float base = inc - run;
        float bb[8], cm[8]; float rm = NEG;
#pragma unroll
        for (int e = 0; e < 8; ++e) { bb[e] = base + lf[e]; const float aa = ip[e] - bb[e]; A2[tid * 8 + e] = aa * LOG2E; rm = fmaxf(rm, aa); cm[e] = rm; }
        float incm = rm;
#pragma unroll
        for (int o = 1; o < 8; o <<= 1) { const float t = shfl_idx(incm, lane - o); if ((lane & 7) >= o) incm = fmaxf(incm, t); }
        float ex = shfl_idx(incm, lane - 1); if ((lane & 7) == 0) ex = NEG;
#pragma unroll
        for (int e = 0; e < 8; ++e) cm[e] = fmaxf(cm[e], ex);
        if ((tid & 7) == 7) { BL[tid >> 3] = bb[7]; AM[tid >> 3] = cm[7]; }
        __syncthreads();
        if (tid < 64) *(LAS unsigned short*)(lds + VT + tid * RSV + 64) = (unsigned short)0x3F80;
        if (tid == 0) { float m = 0.f; for (int c = 0; c < SEQ / MLCH; ++c) { MC[c] = m; m = BL[c] + fmaxf(m, AM[c]); } }
        __syncthreads();
        const float mc = MC[tid >> 3];
#pragma unroll
        for (int e = 0; e < 8; ++e) { const float M = fmaxf(mc, cm[e]); M2[tid * 8 + e] = M * LOG2E; NB[tid * 8 + e] = __builtin_amdgcn_exp2f(-(bb[e] + M) * LOG2E); }
        __syncthreads();
        if (tid < 64) MC[tid] *= LOG2E;
        __syncthreads();
    }
    const bf16* pbase = PROJ + (size_t)b * SEQ * ML_N;
    const int qcol = L_Q + h * 128, kcol = L_K + h * 128, vcol = L_V + h * 256 + vs * 32, ocol = L_O + h * 256 + vs * 32;
    v4u rq[2], rk[2], rv = (v4u){zl, zl, zl, zl};
#define MLS_LOAD(c) do { const bf16* rb = pbase + (size_t)((c) * MLCH) * ML_N;                                                          \
        _Pragma("unroll") for (int i = 0; i < 2; ++i) { const int id = tid + NTHREADS * i, row = id >> 4, ch = id & 15;               \
            rq[i] = *(const v4u*)(rb + (size_t)row * ML_N + qcol + ch * 8); rk[i] = *(const v4u*)(rb + (size_t)row * ML_N + kcol + ch * 8); } \
        if (tid < 256) rv = *(const v4u*)(rb + (size_t)(tid >> 2) * ML_N + vcol + (tid & 3) * 8); } while (0)
    MLS_LOAD(0);
    f32x16 CA0 = {}, CA1 = {};
    const unsigned ldsb = (unsigned)(uintptr_t)lds;
    const int blk = (lane >> 4) & 1, q4 = (lane & 15) >> 2, p4 = lane & 3;
    for (int c = 0; c < SEQ / MLCH; ++c) {
        const int cb = c * MLCH;
        {
#pragma unroll
            for (int i = 0; i < 2; ++i) { const int id = tid + NTHREADS * i, row = id >> 4, ch = id & 15;
                *(LAS v4u*)(lds + QT + row * RS + ch * 16) = rq[i]; *(LAS v4u*)(lds + KT + row * RS + ch * 16) = rk[i]; }
            const float m63 = M2[cb + 63];
            if (tid < 256) { const int row = tid >> 2, ch = tid & 3; *(LAS v4u*)(lds + VT + row * RSV + ch * 16) = rv;
                const float w = __builtin_amdgcn_exp2f(A2[cb + row] - m63) * SCALE; v4u o;
#pragma unroll
                for (int e = 0; e < 4; ++e) o[e] = pk2(bflo(rv[e]) * w, bfhi(rv[e]) * w);
                *(LAS v4u*)(lds + VW + row * RSV + ch * 16) = o; }
            else if (tid < 320) { const int row = tid - 256; const float w = __builtin_amdgcn_exp2f(A2[cb + row] - m63) * SCALE;
                *(LAS v4u*)(lds + VW + row * RSV + 64) = (v4u){f2bf(w), zl, zl, zl}; }
        }
        __syncthreads();
        if (c + 1 < SEQ / MLCH) MLS_LOAD(c + 1);
        if (wid < 2) {
            const int tb = wid;
            const size_t grow0 = (size_t)(b * SEQ + cb + 32 * tb);
            unsigned short og[16];
#pragma unroll
            for (int rr = 0; rr < 16; ++rr) og[rr] = pbase[(size_t)(cb + 32 * tb + crow(rr, hh)) * ML_N + ocol + r];
            bf16x8 qf[8];
#pragma unroll
            for (int s = 0; s < 8; ++s) qf[s] = *(const LAS bf16x8*)(lds + QT + (32 * tb + r) * RS + (16 * s + 8 * hh) * 2);
            f32x16 acc0 = {}, acc1 = {};
#pragma unroll
            for (int s = 0; s < 8; ++s) { const bf16x8 c0 = *(const LAS bf16x8*)(lds + CB + r * RS + (16 * s + 8 * hh) * 2), c1 = *(const LAS bf16x8*)(lds + CB + (32 + r) * RS + (16 * s + 8 * hh) * 2);
                acc0 = __builtin_amdgcn_mfma_f32_32x32x16_bf16(qf[s], c0, acc0, 0, 0, 0); acc1 = __builtin_amdgcn_mfma_f32_32x32x16_bf16(qf[s], c1, acc1, 0, 0, 0); }
            const float mc2 = MC[c];
#pragma unroll
            for (int g = 0; g < 4; ++g) { const f32x4 m4 = *(const LAS f32x4*)(M2 + cb + 32 * tb + 8 * g + 4 * hh);
#pragma unroll
                for (int e = 0; e < 4; ++e) { const float it = __builtin_amdgcn_exp2f(mc2 - m4[e]); acc0[4 * g + e] *= it; acc1[4 * g + e] *= it; } }
            const float m2t = M2[cb + 32 * tb + r];
            const unsigned vbase = ldsb + VT + (8 * hh + q4) * RSV + (16 * blk + 4 * p4) * 2;
#pragma unroll
            for (int sb = 0; sb < 2; ++sb) {
                if (sb <= tb) {
                    f32x16 p = {};
#pragma unroll
                    for (int s = 0; s < 8; ++s) { const bf16x8 kf = *(const LAS bf16x8*)(lds + KT + (32 * sb + r) * RS + (16 * s + 8 * hh) * 2); p = __builtin_amdgcn_mfma_f32_32x32x16_bf16(kf, qf[s], p, 0, 0, 0); }
#pragma unroll
                    for (int g = 0; g < 4; ++g) { const f32x4 a4 = *(const LAS f32x4*)(A2 + cb + 32 * sb + 8 * g + 4 * hh);
#pragma unroll
                        for (int e = 0; e < 4; ++e) { const float w = __builtin_amdgcn_exp2f(a4[e] - m2t) * SCALE; float val = p[4 * g + e] * w;
                            if (sb == tb && (8 * g + 4 * hh + e) > r) val = 0.f;
                            p[4 * g + e] = val; } }
                    bf16x8 pa0, pa1; MLS_PK4(p, 0, pa0); MLS_PK4(p, 8, pa1);
                    s16x4 l0, h0, l1, h1, l2, h2, l3, h3;
                    if (sb == 0) { MLS_TR(l0, vbase, 0); MLS_TR(h0, vbase, 4 * RSV); MLS_TR(l1, vbase, 64); MLS_TR(h1, vbase, 64 + 4 * RSV);
                                   MLS_TR(l2, vbase, 16 * RSV); MLS_TR(h2, vbase, 20 * RSV); MLS_TR(l3, vbase, 16 * RSV + 64); MLS_TR(h3, vbase, 20 * RSV + 64); }
                    else         { MLS_TR(l0, vbase, 32 * RSV); MLS_TR(h0, vbase, 36 * RSV); MLS_TR(l1, vbase, 32 * RSV + 64); MLS_TR(h1, vbase, 36 * RSV + 64);
                                   MLS_TR(l2, vbase, 48 * RSV); MLS_TR(h2, vbase, 52 * RSV); MLS_TR(l3, vbase, 48 * RSV + 64); MLS_TR(h3, vbase, 52 * RSV + 64); }
                    asm volatile("s_waitcnt lgkmcnt(0)" ::: "memory"); __builtin_amdgcn_sched_barrier(0);
                    acc0 = __builtin_amdgcn_mfma_f32_32x32x16_bf16(pa0, (bf16x8){l0[0], l0[1], l0[2], l0[3], h0[0], h0[1], h0[2], h0[3]}, acc0, 0, 0, 0);
                    acc1 = __builtin_amdgcn_mfma_f32_32x32x16_bf16(pa0, (bf16x8){l1[0], l1[1], l1[2], l1[3], h1[0], h1[1], h1[2], h1[3]}, acc1, 0, 0, 0);
                    acc0 = __builtin_amdgcn_mfma_f32_32x32x16_bf16(pa1, (bf16x8){l2[0], l2[1], l2[2], l2[3], h2[0], h2[1], h2[2], h2[3]}, acc0, 0, 0, 0);
                    acc1 = __builtin_amdgcn_mfma_f32_32x32x16_bf16(pa1, (bf16x8){l3[0], l3[1], l3[2], l3[3], h3[0], h3[1], h3[2], h3[3]}, acc1, 0, 0, 0);
                }
            }
#pragma unroll
            for (int g = 0; g < 4; ++g) { const f32x4 nb4 = *(const LAS f32x4*)(NB + cb + 32 * tb + 8 * g + 4 * hh);
#pragma unroll
                for (int e = 0; e < 4; ++e) { const int rr = 4 * g + e; const float dot = shfl_idx(acc1[rr], lane & 32);
                    const float den = fmaxf(fabsf(dot), nb4[e]); const float hv = acc0[rr] / den; const float o = bf2f(og[rr]);
                    HEADS[(grow0 + crow(rr, hh)) * DM + h * 256 + vs * 32 + r] = (bf16)f2bf(hv / (1.f + __expf(-o))); } }
        } else if (wid >= 4) {
            const int u = wid - 4;
            const float decay = __builtin_amdgcn_exp2f(MC[c] - M2[cb + 63]);
#pragma unroll
            for (int rr = 0; rr < 16; ++rr) { CA0[rr] *= decay; CA1[rr] *= decay; }
            const unsigned kbase = ldsb + KT + (8 * hh + q4) * RS + (32 * u + 16 * blk + 4 * p4) * 2;
            const unsigned wbase = ldsb + VW + (8 * hh + q4) * RSV + (16 * blk + 4 * p4) * 2;
#define MLS_UPD(ks) do { s16x4 al, ah, b0l, b0h, b1l, b1h;                                                                        \
                MLS_TR(al, kbase, (ks) * 16 * RS); MLS_TR(ah, kbase, (ks) * 16 * RS + 4 * RS);                                       \
                MLS_TR(b0l, wbase, (ks) * 16 * RSV); MLS_TR(b0h, wbase, (ks) * 16 * RSV + 4 * RSV);                                  \
                MLS_TR(b1l, wbase, (ks) * 16 * RSV + 64); MLS_TR(b1h, wbase, (ks) * 16 * RSV + 4 * RSV + 64);                        \
                asm volatile("s_waitcnt lgkmcnt(0)" ::: "memory"); __builtin_amdgcn_sched_barrier(0);                              \
                const bf16x8 af = (bf16x8){al[0], al[1], al[2], al[3], ah[0], ah[1], ah[2], ah[3]};                                   \
                CA0 = __builtin_amdgcn_mfma_f32_32x32x16_bf16(af, (bf16x8){b0l[0], b0l[1], b0l[2], b0l[3], b0h[0], b0h[1], b0h[2], b0h[3]}, CA0, 0, 0, 0); \
                CA1 = __builtin_amdgcn_mfma_f32_32x32x16_bf16(af, (bf16x8){b1l[0], b1l[1], b1l[2], b1l[3], b1h[0], b1h[1], b1h[2], b1h[3]}, CA1, 0, 0, 0); } while (0)
            MLS_UPD(0); MLS_UPD(1); MLS_UPD(2); MLS_UPD(3);
#undef MLS_UPD
        }
        __syncthreads();
        if (wid >= 4) {
            const int u = wid - 4;
#pragma unroll
            for (int g = 0; g < 4; ++g) {
                v2u w0, w1; w0.x = cvtpk(CA0[4 * g], CA0[4 * g + 1]); w0.y = cvtpk(CA0[4 * g + 2], CA0[4 * g + 3]); w1.x = cvtpk(CA1[4 * g], CA1[4 * g + 1]); w1.y = cvtpk(CA1[4 * g + 2], CA1[4 * g + 3]);
                *(LAS v2u*)(lds + CB + r * RS + (32 * u + 8 * g + 4 * hh) * 2) = w0;
                *(LAS v2u*)(lds + CB + (32 + r) * RS + (32 * u + 8 * g + 4 * hh) * 2) = w1; }
        }
    }
    __syncthreads();
#undef MLS_LOAD
}
__device__ __forceinline__ void mlstm_phase(const bf16* PROJ, const float* GATES, bf16* HEADS, LAS unsigned char* lds, int bx, int G) {
    for (int L = bx; L < NBATCH * MLH * 8; L += G) { const int bh = L >> 3, vs = L & 7; mlstm_unit(PROJ, GATES, HEADS, lds, bh / MLH, bh % MLH, vs); }
}
#undef MLS_TR
#undef MLS_PK4
}
#define MLSTM_PHASE mls::mlstm_phase(PROJ, GATES, HEADS, lds, bx, G);
#ifndef MLSTM_PHASE
#define MLSTM_PHASE ;
#endif

__global__ void __launch_bounds__(NTHREADS, 2) mega(Args a) {
    extern __shared__ __attribute__((aligned(16))) unsigned char lds_raw[];
    LAS unsigned char* lds = (LAS unsigned char*)lds_raw;
    const int tid = threadIdx.x, lane = tid & 63, wave = __builtin_amdgcn_readfirstlane(tid >> 6);
    const int G = gridDim.x, bx = blockIdx.x;
    const int vcu = (G % 8 == 0) ? (bx % 8) * (G / 8) + bx / 8 : bx;
    for (int u = tid; u < (LDS_BYTES - LDSCTL_OFF) / 4; u += NTHREADS) ((LAS unsigned*)(lds + LDSCTL_OFF))[u] = 0u;
    __syncthreads();
    unsigned char* ws = a.ws;
    gu32* ctl = (gu32*)(ws + WS_CTL);
    volatile LAS unsigned* MISC = (volatile LAS unsigned*)(lds + LDSCTL_OFF);
    XcdBarrier bar = xcd_barrier_post((unsigned*)ctl + CW_BAR + a.bar_region * BAR_STRIDE, MISC + 8);
    const int lo = a.ph_lo, hi = a.ph_hi;
#define IN(k) (lo <= (k) && (k) < hi)
#define SEAM(k) do { if (IN(k) && IN((k) + 1)) xcd_barrier(bar); } while (0)
    float* X = (float*)(ws + WS_X); bf16* XB = (bf16*)(ws + WS_XB); bf16* PROJ = (bf16*)(ws + WS_PROJ); bf16* HEADS = (bf16*)(ws + WS_HEADS);
    bf16* UB = (bf16*)(ws + WS_R1); bf16* HB = (bf16*)(ws + WS_H); float* GATES = (float*)(ws + WS_GATES);

    if (IN(0)) p0_prologue(a, lds, vcu, G, wave, lane, tid);
    SEAM(0);
    for (int layer = 0; layer < DEPTH; ++layer) {
        const int j = layer >> 1, odd = layer & 1, pb = 1 + layer * 8;
        const int NGW = G * NWAVES, NGT = G * NTHREADS;
#define LANE_VARS int tl = threadIdx.x; asm volatile("" : "+v"(tl)); const int lane = tl & 63, gw = vcu * NWAVES + __builtin_amdgcn_readfirstlane(tl >> 6), gt = vcu * NTHREADS + tl; (void)lane; (void)gw; (void)gt;
        if (IN(pb)) {
            LANE_VARS
            const bf16* WG = (const bf16*)(ws + WS_WG) + (size_t)(odd ? 2 + j : j) * 32 * DM;
            gates_phase(XB, WG, odd ? a.in[6] + (size_t)j * ML_IN + 6144 : a.in[2] + (size_t)j * ATT_IN + 3072, odd ? 16 : 8, GATES, gw, NGW, lane);
            const int N = odd ? ML_N : ATT_N;
            pg8::Gemm g{XB, odd ? (const bf16*)(ws + WS_WMIN) + (size_t)j * ML_N * DM : (const bf16*)(ws + WS_WAIN) + (size_t)j * ATT_N * DM, MTOK, N, DM};
            pg8::StaticOrder S; S.init(MTOK, N, G, bx);
            pg8::EpiProj E{PROJ, N, odd ? a.in[6] + (size_t)j * ML_IN : (const float*)(ws + WS_BIASA) + (size_t)j * ATT_N, odd ? 0 : A_SQ / 256, odd ? 0 : A_SV / 256, (const float*)(ws + WS_ROPE)};
            pg8::gemm_phase<pg8::EpiProj, pg8::StaticOrder, true, true>(lds, g, S, E);
        }
        SEAM(pb);
        if (IN(pb + 1)) {
#if !NAIVE_ATTN
            if (!odd) for (int rep = 0; rep < REP_ATTN; ++rep) att::attn_phase(PROJ, GATES, a.in[3] + (size_t)j * SWAQ, HEADS, (char*)lds_raw, bx, G);
#endif
#if !NAIVE_MLSTM
            if (odd) for (int rep = 0; rep < REP_MLSTM; ++rep) { MLSTM_PHASE }
#endif
        }
        SEAM(pb + 1);
        if (IN(pb + 2)) {
            pg8::Gemm g{HEADS, odd ? (const bf16*)(ws + WS_WMOUT) + (size_t)j * DM * DM : (const bf16*)(ws + WS_WAOUT) + (size_t)j * DM * DM, MTOK, DM, DM};
            pg8::StaticOrder S; S.init(MTOK, DM, G, bx);
            pg8::EpiResid E{X, DM, DN_ALPHA};
            pg8::gemm_phase<pg8::EpiResid, pg8::StaticOrder, true, true>(lds, g, S, E);
        }
        SEAM(pb + 2);
        if (IN(pb + 3)) { LANE_VARS ln_phase(X, X, XB, a.in[12] + (size_t)layer * DM, a.in[13] + (size_t)layer * DM, gw, NGW, lane); }
        SEAM(pb + 3);
        if (IN(pb + 4)) {
            pg8::Gemm g{XB, (const bf16*)(ws + WS_WUP) + (size_t)layer * UPN * DM, MTOK, UPN, DM};
            pg8::StaticOrder S; S.init(MTOK, UPN, G, bx);
#if FUSE_CONV
            pg8::EpiConv E{HB, (const float*)(ws + WS_CONVW) + (size_t)layer * 3 * UPN, (const float*)(ws + WS_CONVB) + (size_t)layer * UPN, (float*)(ws + WS_HALO), (float*)(ws + WS_RAW0), (LAS float*)(lds + XCH_OFF)};
            pg8::gemm_phase<pg8::EpiConv, pg8::StaticOrder, true, true>(lds, g, S, E);
#else
            pg8::EpiStoreBf16 E{UB, UPN};
            pg8::gemm_phase<pg8::EpiStoreBf16, pg8::StaticOrder, true, true>(lds, g, S, E);
#endif
        }
        SEAM(pb + 4);
#if FUSE_CONV
        if (IN(pb + 5)) { LANE_VARS conv_fix_phase((const float*)(ws + WS_HALO), (const float*)(ws + WS_RAW0), HB, (const float*)(ws + WS_CONVW) + (size_t)layer * 3 * UPN, (const float*)(ws + WS_CONVB) + (size_t)layer * UPN, gt, NGT); }
#else
        if (IN(pb + 5)) for (int rep = 0; rep < REP_CONV; ++rep) { LANE_VARS conv_phase(UB, HB, (const float*)(ws + WS_CONVW) + (size_t)layer * 3 * UPN, (const float*)(ws + WS_CONVB) + (size_t)layer * UPN, gt, NGT); }
#endif
        SEAM(pb + 5);
        if (IN(pb + 6)) {
            pg8::Gemm g{HB, (const bf16*)(ws + WS_WDN) + (size_t)layer * DM * DFF, MTOK, DM, DFF};
            pg8::StaticOrder S; S.init(MTOK, DM, G, bx);
            pg8::EpiResid E{X, DM, DN_ALPHA};
            pg8::gemm_phase<pg8::EpiResid, pg8::StaticOrder, true, true>(lds, g, S, E);
        }
        SEAM(pb + 6);
        if (IN(pb + 7)) { LANE_VARS const bool lastl = layer == DEPTH - 1; ln_phase(X, lastl ? a.out : X, lastl ? (bf16*)nullptr : XB, a.in[14] + (size_t)layer * DM, a.in[15] + (size_t)layer * DM, gw, NGW, lane); }
        SEAM(pb + 7);
    }
#undef IN
#undef LANE_VARS
#undef SEAM
}


#if NAIVE_ATTN || NAIVE_MLSTM
__global__ void naive_fox_c(const float* GATES, float* C) {
    const int i = blockIdx.x * blockDim.x + threadIdx.x; if (i >= NBATCH * FOXH) return;
    const int b = i / FOXH, h = i % FOXH; double acc = 0.0;
    for (int t = 0; t < SEQ; ++t) { acc += (double)log_sigmoid(GATES[(size_t)(b * SEQ + t) * 16 + h]); C[(size_t)i * SEQ + t] = (float)acc; }
}
__global__ __launch_bounds__(64) void naive_attn(const bf16* PROJ, const float* C, const float* sinks, bf16* HEADS) {
    __shared__ float lg[SEQ];
    const int lane = threadIdx.x, id = blockIdx.x;
    const int t = id % SEQ, hd = (id / SEQ) % 16, b = id / (SEQ * 16);
    const bool fox = hd < 8;
    const int qc = fox ? A_FQ + hd * 128 : A_SQ + (hd - 8) * 128, kc = fox ? A_FK + hd * 128 : A_SK + ((hd - 8) / 4) * 128, vc = fox ? A_FV + hd * 128 : A_SV + ((hd - 8) / 4) * 128;
    const bf16* qp = PROJ + (size_t)(b * SEQ + t) * ATT_N + qc;
    v4u q[16];
#pragma unroll
    for (int i = 0; i < 16; ++i) q[i] = *(const v4u*)(qp + 8 * i);
    const int lo = fox ? 0 : (t - (SWAW - 1) > 0 ? t - (SWAW - 1) : 0);
    const float ct = fox ? C[(size_t)(b * FOXH + hd) * SEQ + t] : 0.f;
    float mx = -3.0e38f;
    for (int s = lo + lane; s <= t; s += 64) {
        const bf16* kp = PROJ + (size_t)(b * SEQ + s) * ATT_N + kc; float dot = 0.f;
#pragma unroll
        for (int i = 0; i < 16; ++i) { const v4u kv = *(const v4u*)(kp + 8 * i);
#pragma unroll
            for (int e = 0; e < 4; ++e) dot += bflo(q[i][e]) * bflo(kv[e]) + bfhi(q[i][e]) * bfhi(kv[e]); }
        float lgt = dot * 0.08838834764831845f; if (fox) lgt += ct - C[(size_t)(b * FOXH + hd) * SEQ + s];
        lg[s - lo] = lgt; mx = fmaxf(mx, lgt);
    }
    mx = wave_max(mx);
    const float sink = fox ? 0.f : sinks[hd - 8];
    if (!fox) mx = fmaxf(mx, sink);
    float sum = 0.f;
    for (int s = lo + lane; s <= t; s += 64) { const float p = expf(lg[s - lo] - mx); lg[s - lo] = p; sum += p; }
    sum = wave_sum(sum); if (!fox) sum += expf(sink - mx);
    __syncthreads();
    float a0 = 0.f, a1 = 0.f;
    for (int s = lo; s <= t; ++s) { const float p = lg[s - lo]; const unsigned w = *(const unsigned*)(PROJ + (size_t)(b * SEQ + s) * ATT_N + vc + 2 * lane); a0 += p * bflo(w); a1 += p * bfhi(w); }
    const float inv = 1.f / sum;
    *(unsigned*)(HEADS + (size_t)(b * SEQ + t) * DM + hd * 128 + 2 * lane) = pk2(a0 * inv, a1 * inv);
}
__global__ __launch_bounds__(320) void naive_mlstm(const bf16* PROJ, const float* GATES, bf16* HEADS) {
    __shared__ float sk[128], sq[128], sdot[1];
    const int b = blockIdx.x / MLH, h = blockIdx.x % MLH, tid = threadIdx.x;
    float Cr[128];
#pragma unroll
    for (int d = 0; d < 128; ++d) Cr[d] = 0.f;
    float m = 0.f;
    for (int t = 0; t < SEQ; ++t) {
        const size_t row = (size_t)(b * SEQ + t);
        if (tid < 128) sk[tid] = bf2f(PROJ[row * ML_N + L_K + h * 128 + tid]) * 0.08838834764831845f;
        else if (tid < 256) sq[tid - 128] = bf2f(PROJ[row * ML_N + L_Q + h * 128 + tid - 128]);
        const float ip = GATES[row * 16 + h], fp = GATES[row * 16 + 8 + h];
        const float lf = log_sigmoid(fp), mn = fmaxf(lf + m, ip), fC = expf(lf + m - mn), iw = expf(ip - mn); m = mn;
        const float vv = tid < 256 ? bf2f(PROJ[row * ML_N + L_V + h * 256 + tid]) : 1.0f;
        __syncthreads();
        float num = 0.f; const float iv = iw * vv;
#pragma unroll
        for (int d = 0; d < 128; ++d) { Cr[d] = fC * Cr[d] + iv * sk[d]; num += Cr[d] * sq[d]; }
        if (tid == 256) sdot[0] = num;
        __syncthreads();
        if (tid < 256) { const float den = fmaxf(fabsf(sdot[0]), expf(-m)); const float hh = num / den; const float o = bf2f(PROJ[row * ML_N + L_O + h * 256 + tid]);
            HEADS[row * DM + h * 256 + tid] = (bf16)f2bf(hh / (1.f + expf(-o))); }
    }
}
#endif


static void launch_mega(Args a, int lo, int hi, int region, int grid, hipStream_t stream) {
    a.ph_lo = lo; a.ph_hi = hi; a.bar_region = region; a.pad = 0;
    hipLaunchKernelGGL(mega, dim3(grid), dim3(NTHREADS), LDS_BYTES, stream, a);
    const hipError_t le = hipPeekAtLastError();
    if (le != hipSuccess) fprintf(stderr, "kernel_launch: mega[%d,%d) failed: %s\n", lo, hi, hipGetErrorName(le));
}
extern "C" void kernel_launch(void* const* d_in, const int* in_sizes, int n_in, void* d_out, int out_size, void* d_ws, size_t ws_size, hipStream_t stream) {
    static int grid = 0;
    if (grid == 0) {
        if (n_in != 16 || in_sizes[0] != MTOK * DM || out_size != MTOK * DM || ws_size < WS_NEED) {
            fprintf(stderr, "kernel_launch: unexpected shapes (n_in %d, in0 %d, out %d, ws %zu < %zu); nothing launched\n", n_in, n_in > 0 ? in_sizes[0] : -1, out_size, ws_size, (size_t)WS_NEED); grid = -1; return; }
        int dev = 0, cus = 0, per_cu = 0;
        if (hipGetDevice(&dev) != hipSuccess || hipDeviceGetAttribute(&cus, hipDeviceAttributeMultiprocessorCount, dev) != hipSuccess) { fprintf(stderr, "kernel_launch: device query failed\n"); grid = -1; return; }
        if (hipFuncSetAttribute((const void*)mega, hipFuncAttributeMaxDynamicSharedMemorySize, LDS_BYTES) != hipSuccess) { fprintf(stderr, "kernel_launch: hipFuncSetAttribute failed\n"); grid = -1; return; }
        if (hipOccupancyMaxActiveBlocksPerMultiprocessor(&per_cu, (const void*)mega, NTHREADS, LDS_BYTES) != hipSuccess || per_cu < 1)
            fprintf(stderr, "kernel_launch: note: occupancy query reports %d workgroups per CU\n", per_cu);
        (void)hipGetLastError();
        grid = cus;
    }
    if (grid < 0) return;
    if (hipMemsetAsync((char*)d_ws + WS_CTL, 0, CTL_ZERO_BYTES, stream) != hipSuccess) { fprintf(stderr, "kernel_launch: memset failed\n"); return; }
    Args a{};
    for (int i = 0; i < 16; ++i) a.in[i] = (const float*)d_in[i];
    a.out = (float*)d_out; a.ws = (unsigned char*)d_ws;
    unsigned char* ws = (unsigned char*)d_ws; (void)ws;
    int region = 0, lo = 0;
    for (int layer = 0; layer < DEPTH; ++layer) {
        const int pb = 1 + layer * 8, j = layer >> 1; (void)j;
#if NAIVE_ATTN
        if ((layer & 1) == 0) {
            launch_mega(a, lo, pb + 1, region++, grid, stream); lo = pb + 2;
            hipLaunchKernelGGL(naive_fox_c, dim3(1), dim3(64), 0, stream, (const float*)(ws + WS_GATES), (float*)(ws + WS_FOXC));
            hipLaunchKernelGGL(naive_attn, dim3(NBATCH * 16 * SEQ), dim3(64), 0, stream, (const bf16*)(ws + WS_PROJ), (const float*)(ws + WS_FOXC), a.in[3] + (size_t)j * SWAQ, (bf16*)(ws + WS_HEADS));
        }
#endif
#if NAIVE_MLSTM
        if ((layer & 1) == 1) {
            launch_mega(a, lo, pb + 1, region++, grid, stream); lo = pb + 2;
            hipLaunchKernelGGL(naive_mlstm, dim3(NBATCH * MLH), dim3(320), 0, stream, (const bf16*)(ws + WS_PROJ), (const float*)(ws + WS_GATES), (bf16*)(ws + WS_HEADS));
        }
#endif
    }
    launch_mega(a, lo, 1 + DEPTH * 8, region++, grid, stream);
}
```
